# Optimizing an MI355X kernel written in HIP

```python
import jax, jax.numpy as jnp
from jax import lax
import numpy as np

D_MODEL = 2048
BATCH = 4
SEQ = 4096
DEPTH = 1

PLE_DIM = 256
RW_HEADS = 16
RW_HEAD_DIM = 64
RW_WIDTH = RW_HEADS * RW_HEAD_DIM
DECAY_LORA = 64
AAA_LORA = 64
FOX_HEADS = 16
FOX_HEAD_DIM = 64
FOX_WIDTH = FOX_HEADS * FOX_HEAD_DIM
Q_BLOCK = 128
NORM_EPS = 1e-6
GN_EPS = 64e-5

RW_COLS = 4 * RW_WIDTH + DECAY_LORA + AAA_LORA
FOX_COLS = 4 * FOX_WIDTH + FOX_HEADS
GATE_COLS = 2 * D_MODEL
N_IN = RW_COLS + FOX_COLS + GATE_COLS

kernel_name = 'hybrid_rwkv7_fox_gated_merge'


def _rmsnorm(x, g):
    xf = x.astype(jnp.float32)
    y = xf * lax.rsqrt(jnp.mean(xf * xf, axis=-1, keepdims=True) + NORM_EPS)
    return (y * g.astype(jnp.float32)).astype(x.dtype)


def _token_shift(z, mu):
    z_prev = jnp.pad(z, ((0, 0), (1, 0), (0, 0)))[:, :-1]
    return z + (z_prev - z) * mu


def _rwkv7_scan(r, w, k, v, kk, a):
    def step(S, inp):
        r_t, w_t, k_t, v_t, kk_t, a_t = inp
        s_kk = jnp.einsum('bhvk,bhk->bhv', S, kk_t)
        S = (S * w_t[:, :, None, :]
             - s_kk[..., None] * (kk_t * a_t)[:, :, None, :]
             + v_t[..., None] * k_t[:, :, None, :])
        y_t = jnp.einsum('bhvk,bhk->bhv', S, r_t)
        return S, y_t
    B, T, H, N = r.shape
    S0 = jnp.zeros((B, H, N, N), jnp.float32)
    xs = tuple(jnp.swapaxes(t, 0, 1) for t in (r, w, k, v, kk, a))
    _, ys = lax.scan(step, S0, xs)
    return jnp.swapaxes(ys, 0, 1)


def _rwkv7_branch(z, w0, w_lora_up, a0, a_lora_up, k_k, k_a, r_k, ln_g, ln_b):
    B, T, _ = z.shape
    f32 = jnp.float32
    C = RW_WIDTH
    r = z[..., 0:C]
    k = z[..., C:2 * C]
    v = z[..., 2 * C:3 * C]
    g = z[..., 3 * C:4 * C]
    wl = z[..., 4 * C:4 * C + DECAY_LORA]
    al = z[..., 4 * C + DECAY_LORA:]
    w_raw = (w0 + jnp.tanh(wl) @ w_lora_up).astype(f32)
    decay = jnp.exp(-jnp.exp(-jax.nn.softplus(-w_raw) - 0.5))
    a = jax.nn.sigmoid((a0 + al @ a_lora_up).astype(f32))
    hs = lambda t: t.astype(f32).reshape(B, T, RW_HEADS, RW_HEAD_DIM)
    r_h, k_h, v_h, a_h, w_h = hs(r), hs(k), hs(v), hs(a), hs(decay)
    kk = k_h * k_k.astype(f32).reshape(RW_HEADS, RW_HEAD_DIM)
    kk = kk / jnp.maximum(jnp.sqrt(jnp.sum(kk * kk, axis=-1, keepdims=True)), 1e-12)
    k_h = k_h * (1.0 + (a_h - 1.0) * k_a.astype(f32).reshape(RW_HEADS, RW_HEAD_DIM))
    y = _rwkv7_scan(r_h, w_h, k_h, v_h, kk, a_h)
    mu = jnp.mean(y, axis=-1, keepdims=True)
    var = jnp.mean(jnp.square(y - mu), axis=-1, keepdims=True)
    y = ((y - mu) * lax.rsqrt(var + GN_EPS)).reshape(B, T, C)
    y = y * ln_g.astype(f32) + ln_b.astype(f32)
    bonus = jnp.sum(r_h * k_h * r_k.astype(f32), axis=-1, keepdims=True) * v_h
    y = y + bonus.reshape(B, T, C)
    return (y * jax.nn.silu(g.astype(f32))).astype(z.dtype)


def _fox_branch(z, b_f):
    B, T, _ = z.shape
    f32 = jnp.float32
    C = FOX_WIDTH
    to_heads = lambda t: t.astype(f32).reshape(B, T, FOX_HEADS, FOX_HEAD_DIM).transpose(0, 2, 1, 3)
    qh = to_heads(z[..., 0:C])
    kh = to_heads(z[..., C:2 * C])
    vh = to_heads(z[..., 2 * C:3 * C])
    g = z[..., 3 * C:4 * C]
    fl = z[..., 4 * C:]
    log_f = jax.nn.log_sigmoid((fl + b_f).astype(f32))
    c = jnp.cumsum(log_f, axis=1).transpose(0, 2, 1)
    scale = FOX_HEAD_DIM ** -0.5
    outs = []
    for blk in range(T // Q_BLOCK):
        s = blk * Q_BLOCK
        e = s + Q_BLOCK
        logits = jnp.einsum('bhqd,bhkd->bhqk', qh[:, :, s:e], kh[:, :, :e]) * scale
        logits = logits + (c[:, :, s:e, None] - c[:, :, None, :e])
        causal = jnp.arange(s, e)[:, None] >= jnp.arange(e)[None, :]
        logits = jnp.where(causal, logits, -jnp.inf)
        probs = jax.nn.softmax(logits, axis=-1)
        outs.append(jnp.einsum('bhqk,bhkd->bhqd', probs, vh[:, :, :e]))
    o = jnp.concatenate(outs, axis=2).transpose(0, 2, 1, 3).reshape(B, T, C)
    return (o * jax.nn.silu(g.astype(f32))).astype(z.dtype)


def setup_inputs(seed: int = 0) -> dict:
    key = jax.random.key(seed)
    ks = jax.random.split(key, 24)
    f32 = jnp.float32
    nrm = lambda k, shape, s: jax.random.normal(k, shape, f32) * s
    C = RW_WIDTH
    return {
        'x': nrm(ks[0], (BATCH, SEQ, D_MODEL), 1.0),
        'p': nrm(ks[1], (DEPTH, BATCH, SEQ, PLE_DIM), 1.0),
        'norm_g': 1.0 + nrm(ks[2], (DEPTH, D_MODEL), 0.02),
        'w_in': nrm(ks[3], (DEPTH, D_MODEL, N_IN), D_MODEL ** -0.5),
        'rw_shift_mu': jax.random.uniform(ks[4], (DEPTH, RW_COLS), f32),
        'rw_w0': jax.random.uniform(ks[5], (DEPTH, C), f32, -6.0, -1.0),
        'rw_w_lora_up': nrm(ks[6], (DEPTH, DECAY_LORA, C), 0.1 * DECAY_LORA ** -0.5),
        'rw_a0': nrm(ks[7], (DEPTH, C), 0.1),
        'rw_a_lora_up': nrm(ks[8], (DEPTH, AAA_LORA, C), 0.1 * AAA_LORA ** -0.5),
        'rw_k_k': 0.85 + nrm(ks[9], (DEPTH, C), 0.02),
        'rw_k_a': 1.0 + nrm(ks[10], (DEPTH, C), 0.02),
        'rw_r_k': nrm(ks[11], (DEPTH, RW_HEADS, RW_HEAD_DIM), 0.1),
        'rw_ln_g': 1.0 + nrm(ks[12], (DEPTH, C), 0.02),
        'rw_ln_b': nrm(ks[13], (DEPTH, C), 0.02),
        'fox_b_f': jax.random.uniform(ks[14], (DEPTH, FOX_HEADS), f32, 1.0, 5.0),
        'w_up_rwkv': nrm(ks[15], (DEPTH, RW_WIDTH, D_MODEL), RW_WIDTH ** -0.5),
        'w_up_fox': nrm(ks[16], (DEPTH, FOX_WIDTH, D_MODEL), FOX_WIDTH ** -0.5),
        'w_out': nrm(ks[17], (DEPTH, D_MODEL, D_MODEL), D_MODEL ** -0.5),
        'ple_proj': nrm(ks[18], (DEPTH, PLE_DIM, D_MODEL), PLE_DIM ** -0.5),
        'ple_gate_w': nrm(ks[19], (DEPTH, D_MODEL, D_MODEL), D_MODEL ** -0.5),
        'ple_norm_g': 1.0 + nrm(ks[20], (DEPTH, D_MODEL), 0.02),
        'final_norm_g': 1.0 + nrm(ks[21], (D_MODEL,), 0.02),
    }


def reference(x, p, norm_g, w_in, rw_shift_mu, rw_w0, rw_w_lora_up, rw_a0, rw_a_lora_up,
              rw_k_k, rw_k_a, rw_r_k, rw_ln_g, rw_ln_b, fox_b_f, w_up_rwkv, w_up_fox, w_out,
              ple_proj, ple_gate_w, ple_norm_g, final_norm_g):
    for i in range(DEPTH):
        h = _rmsnorm(x, norm_g[i])
        z = h @ w_in[i]
        z_rw = _token_shift(z[..., :RW_COLS], rw_shift_mu[i])
        z_fox = z[..., RW_COLS:RW_COLS + FOX_COLS]
        z_gate = z[..., RW_COLS + FOX_COLS:]
        y_rw = _rwkv7_branch(z_rw, rw_w0[i], rw_w_lora_up[i], rw_a0[i], rw_a_lora_up[i],
                             rw_k_k[i], rw_k_a[i], rw_r_k[i], rw_ln_g[i], rw_ln_b[i])
        y_fox = _fox_branch(z_fox, fox_b_f[i])
        u_rw = y_rw @ w_up_rwkv[i]
        u_fox = y_fox @ w_up_fox[i]
        merged = (jax.nn.sigmoid(z_gate[..., :D_MODEL]) * u_rw
                  + jax.nn.sigmoid(z_gate[..., D_MODEL:]) * u_fox)
        x = x + merged @ w_out[i]
        ple = p[i] @ ple_proj[i]
        x = x + ple * jax.nn.sigmoid(_rmsnorm(x, ple_norm_g[i]) @ ple_gate_w[i])
    return _rmsnorm(x, final_norm_g)
```

```cpp
#include <hip/hip_runtime.h>
#include <cstdio>
#include <cstdint>
__device__ __forceinline__ int lane_id() { int l; asm volatile("v_mbcnt_lo_u32_b32 %0, -1, 0\n\tv_mbcnt_hi_u32_b32 %0, -1, %0" : "=v"(l)); return l; }
namespace pg8 {
#define PG8_LAS __attribute__((address_space(3)))
typedef unsigned short bf16_t;
typedef short bf16x8 __attribute__((ext_vector_type(8)));
typedef float f32x4 __attribute__((ext_vector_type(4)));
typedef unsigned u32x4 __attribute__((ext_vector_type(4)));
constexpr int BM = 256, BK = 64, HALF = 128, HTB = HALF * BK * 2  , STAGE_BYTES = 8 * HTB, NXCD = 8, WGM = 8;

__host__ __device__ __forceinline__ int lds_byte(int r, int c) { const int st = (r >> 4) * 2 + (c >> 5), rr = r & 15, cc = c & 31, ob = rr * 64 + cc * 2; return st * 1024 + (ob ^ (((ob >> 9) & 1) << 5)); }
__host__ __device__ __forceinline__ void stage_rc(int b, int& R, int& C) { const int st = b / 1024, sb = b % 1024, swz = sb ^ (((sb >> 9) & 1) << 5); R = (st >> 1) * 16 + swz / 64; C = (st & 1) * 32 + (swz % 64) / 2; }
__host__ __device__ __forceinline__ int perm32(int rho) { const int n = rho >> 4, i = rho & 15; return 8 * (i >> 2) + 4 * n + (i & 3); }

struct Unit { int pm, pn; };
struct Gemm { const bf16_t* A; const bf16_t* Bt; int M, N, K, lda, ldb; };

struct StaticOrder {
    int nM, nN, nwg, G, c;
    __host__ __device__ void init(int M, int N, int G_, int c_) { nM = M / BM; nN = N / BM; nwg = nM * nN; G = G_; c = c_; }
    __host__ __device__ bool next(int i, Unit& u) const {
        const long L = (long)i * G + c; if (L >= nwg) return false;
        int wgid = (int)L; { const int q = nwg / NXCD, r = nwg % NXCD, xcd = wgid % NXCD, off = wgid / NXCD; wgid = (xcd < r ? xcd * (q + 1) : r * (q + 1) + (xcd - r) * q) + off; }
        const int nig = WGM * nN, gid = wgid / nig, fm = gid * WGM, gsz = (nM - fm) < WGM ? (nM - fm) : WGM;
        u.pm = fm + ((wgid % nig) % gsz); u.pn = (wgid % nig) / gsz; return true;
    }
    __device__ __forceinline__ void a_ready(const Unit&) const {}
    __device__ __forceinline__ void done(const Unit&) const {}
};

__device__ __forceinline__ unsigned cvt_pk_bf16(float lo, float hi) { unsigned r; asm volatile("v_cvt_pk_bf16_f32 %0, %1, %2" : "=v"(r) : "v"(lo), "v"(hi)); return r; }
__device__ __forceinline__ float sigm(float x) { return __builtin_amdgcn_rcpf(1.f + __builtin_amdgcn_exp2f(-1.4426950408889634f * x)); }
__device__ __forceinline__ float bf_lo(unsigned u) { return __uint_as_float(u << 16); }
__device__ __forceinline__ float bf_hi(unsigned u) { return __uint_as_float(u & 0xffff0000u); }
__device__ __forceinline__ u32x4 pack8(const f32x4& v0, const f32x4& v1) { u32x4 w; w.x = cvt_pk_bf16(v0[0], v0[1]); w.y = cvt_pk_bf16(v0[2], v0[3]); w.z = cvt_pk_bf16(v1[0], v1[1]); w.w = cvt_pk_bf16(v1[2], v1[3]); return w; }
__device__ __forceinline__ void unpack8(const u32x4& w, f32x4& v0, f32x4& v1) { v0 = (f32x4){bf_lo(w.x), bf_hi(w.x), bf_lo(w.y), bf_hi(w.y)}; v1 = (f32x4){bf_lo(w.z), bf_hi(w.z), bf_lo(w.w), bf_hi(w.w)}; }
#define PG8_EPI_LOOP _Pragma("unroll") for (int ai = 0; ai < 2; ++ai) _Pragma("unroll") for (int m = 0; m < 4; ++m)

struct EpiZ {
    static constexpr bool PERM = true, AFTER_DRAIN = false;
    bf16_t* Z0; size_t seg_stride; float* ZS; float qscale;
    __device__ __forceinline__ void operator()(const f32x4 (&acc)[2][2][4][2], const Unit& u, int wr, int wc, int fr, int fq) const {
        const int seg = u.pn >> 4, ct = u.pn & 15, row0 = u.pm * BM + wr * 64 + fr;
        if (seg == 3) {
            const int col0 = wc * 32 + 8 * fq;
            PG8_EPI_LOOP { float* rowp = ZS + (size_t)(row0 + ai * HALF + m * 16) * 256 + col0;
#pragma unroll
                for (int bj = 0; bj < 2; ++bj) { *(f32x4*)(rowp + bj * HALF) = acc[ai][bj][m][0]; *(f32x4*)(rowp + bj * HALF + 4) = acc[ai][bj][m][1]; } }
        } else {
            bf16_t* base = Z0 + (size_t)seg * seg_stride;
            const int col0 = ct * 256 + wc * 32 + 8 * fq;
            const float sc = (seg == 1 && ct < 4) ? qscale : 1.f;
            const bool sg = (seg == 2);
            PG8_EPI_LOOP { bf16_t* rowp = base + (size_t)(row0 + ai * HALF + m * 16) * 4096 + col0;
#pragma unroll
                for (int bj = 0; bj < 2; ++bj) { f32x4 v0 = acc[ai][bj][m][0] * sc, v1 = acc[ai][bj][m][1] * sc;
                    if (sg) {
#pragma unroll
                        for (int e = 0; e < 4; ++e) { v0[e] = sigm(v0[e]); v1[e] = sigm(v1[e]); } }
                    *(u32x4*)(rowp + bj * HALF) = pack8(v0, v1); } }
        }
    }
};
struct EpiLora {
    static constexpr bool PERM = true, AFTER_DRAIN = false;
    float* DEC; bf16_t* AG; const float* w0; const float* a0;
    __device__ __forceinline__ void operator()(const f32x4 (&acc)[2][2][4][2], const Unit& u, int wr, int wc, int fr, int fq) const {
        const int row0 = u.pm * BM + wr * 64 + fr; const bool isw = u.pn < 4;
        const int col0 = (u.pn & 3) * 256 + wc * 32 + 8 * fq; const float* bias = isw ? w0 : a0;
        f32x4 bv[2][2];
#pragma unroll
        for (int bj = 0; bj < 2; ++bj) { bv[bj][0] = *(const f32x4*)(bias + col0 + bj * HALF); bv[bj][1] = *(const f32x4*)(bias + col0 + bj * HALF + 4); }
        PG8_EPI_LOOP { const size_t ro = (size_t)(row0 + ai * HALF + m * 16) * 1024 + col0;
#pragma unroll
            for (int bj = 0; bj < 2; ++bj) { f32x4 v0 = acc[ai][bj][m][0] + bv[bj][0], v1 = acc[ai][bj][m][1] + bv[bj][1];
#pragma unroll
                for (int e = 0; e < 4; ++e) { v0[e] = sigm(v0[e]); v1[e] = sigm(v1[e]); }
                if (isw) {
#pragma unroll
                    for (int e = 0; e < 4; ++e) { v0[e] = __builtin_amdgcn_exp2f(-0.8750612634f * v0[e]); v1[e] = __builtin_amdgcn_exp2f(-0.8750612634f * v1[e]); }
                    *(f32x4*)(DEC + ro + bj * HALF) = v0; *(f32x4*)(DEC + ro + bj * HALF + 4) = v1;
                } else *(u32x4*)(AG + ro + bj * HALF) = pack8(v0, v1); } }
    }
};
struct EpiPlain {
    static constexpr bool PERM = true, AFTER_DRAIN = false;
    bf16_t* O; int ldc;
    __device__ __forceinline__ void operator()(const f32x4 (&acc)[2][2][4][2], const Unit& u, int wr, int wc, int fr, int fq) const {
        const int row0 = u.pm * BM + wr * 64 + fr, col0 = u.pn * BM + wc * 32 + 8 * fq;
        PG8_EPI_LOOP { bf16_t* rowp = O + (size_t)(row0 + ai * HALF + m * 16) * ldc + col0;
#pragma unroll
            for (int bj = 0; bj < 2; ++bj) *(u32x4*)(rowp + bj * HALF) = pack8(acc[ai][bj][m][0], acc[ai][bj][m][1]); }
    }
};
struct EpiT1 {
    static constexpr bool PERM = true, AFTER_DRAIN = false;
    bf16_t* T1; const bf16_t* ZG;
    __device__ __forceinline__ void operator()(const f32x4 (&acc)[2][2][4][2], const Unit& u, int wr, int wc, int fr, int fq) const {
        const int row0 = u.pm * BM + wr * 64 + fr, col0 = u.pn * BM + wc * 32 + 8 * fq;
        PG8_EPI_LOOP { const size_t r = (size_t)(row0 + ai * HALF + m * 16);
#pragma unroll
            for (int bj = 0; bj < 2; ++bj) { f32x4 g0, g1; unpack8(*(const u32x4*)(ZG + r * 4096 + col0 + bj * HALF), g0, g1);
                *(u32x4*)(T1 + r * 2048 + col0 + bj * HALF) = pack8(acc[ai][bj][m][0] * g0, acc[ai][bj][m][1] * g1); } }
    }
};
struct EpiMerge {
    static constexpr bool PERM = true, AFTER_DRAIN = false;
    const bf16_t* T1; const bf16_t* ZG; bf16_t* MG;
    __device__ __forceinline__ void operator()(const f32x4 (&acc)[2][2][4][2], const Unit& u, int wr, int wc, int fr, int fq) const {
        const int row0 = u.pm * BM + wr * 64 + fr, col0 = u.pn * BM + wc * 32 + 8 * fq;
        PG8_EPI_LOOP { const size_t r = (size_t)(row0 + ai * HALF + m * 16);
#pragma unroll
            for (int bj = 0; bj < 2; ++bj) { f32x4 g0, g1, t0, t1; unpack8(*(const u32x4*)(ZG + r * 4096 + 2048 + col0 + bj * HALF), g0, g1); unpack8(*(const u32x4*)(T1 + r * 2048 + col0 + bj * HALF), t0, t1);
                *(u32x4*)(MG + r * 2048 + col0 + bj * HALF) = pack8(t0 + acc[ai][bj][m][0] * g0, t1 + acc[ai][bj][m][1] * g1); } }
    }
};
struct EpiX1 {
    static constexpr bool PERM = true, AFTER_DRAIN = false;
    const float* X; float* X1; bf16_t* X1B; float* SS;
    __device__ __forceinline__ void operator()(const f32x4 (&acc)[2][2][4][2], const Unit& u, int wr, int wc, int fr, int fq) const {
        const int row0 = u.pm * BM + wr * 64 + fr, col0 = u.pn * BM + wc * 32 + 8 * fq;
        PG8_EPI_LOOP { const size_t r = (size_t)(row0 + ai * HALF + m * 16); float ss = 0.f;
#pragma unroll
            for (int bj = 0; bj < 2; ++bj) { const size_t o = r * 2048 + col0 + bj * HALF;
                const f32x4 v0 = acc[ai][bj][m][0] + *(const f32x4*)(X + o), v1 = acc[ai][bj][m][1] + *(const f32x4*)(X + o + 4);
                *(f32x4*)(X1 + o) = v0; *(f32x4*)(X1 + o + 4) = v1; *(u32x4*)(X1B + o) = pack8(v0, v1);
                ss += (v0[0] * v0[0] + v0[1] * v0[1]) + (v0[2] * v0[2] + v0[3] * v0[3]) + (v1[0] * v1[0] + v1[1] * v1[1]) + (v1[2] * v1[2] + v1[3] * v1[3]); }
            ss += __shfl_xor(ss, 16); ss += __shfl_xor(ss, 32);
            if (fq == 0) SS[r * 32 + u.pn * 4 + wc] = ss; }
    }
};
struct EpiX2 {
    static constexpr bool PERM = true, AFTER_DRAIN = false;
    const float* X1; const bf16_t* PLE; const float* SS1; float* OUT; float* SS2; float eps;
    __device__ __forceinline__ void operator()(const f32x4 (&acc)[2][2][4][2], const Unit& u, int wr, int wc, int fr, int fq) const {
        const int row0 = u.pm * BM + wr * 64 + fr, col0 = u.pn * BM + wc * 32 + 8 * fq;
        PG8_EPI_LOOP { const size_t r = (size_t)(row0 + ai * HALF + m * 16);
            const f32x4 p0 = *(const f32x4*)(SS1 + r * 32 + fq * 8), p1 = *(const f32x4*)(SS1 + r * 32 + fq * 8 + 4);
            float s1 = (p0[0] + p0[1]) + (p0[2] + p0[3]) + (p1[0] + p1[1]) + (p1[2] + p1[3]); s1 += __shfl_xor(s1, 16); s1 += __shfl_xor(s1, 32);
            const float rstd = __builtin_amdgcn_rsqf(s1 * (1.f / 2048.f) + eps); float ss = 0.f;
#pragma unroll
            for (int bj = 0; bj < 2; ++bj) { const size_t o = r * 2048 + col0 + bj * HALF; f32x4 e0, e1; unpack8(*(const u32x4*)(PLE + o), e0, e1);
                f32x4 v0 = *(const f32x4*)(X1 + o), v1 = *(const f32x4*)(X1 + o + 4);
#pragma unroll
                for (int e = 0; e < 4; ++e) { v0[e] += e0[e] * sigm(acc[ai][bj][m][0][e] * rstd); v1[e] += e1[e] * sigm(acc[ai][bj][m][1][e] * rstd); }
                *(f32x4*)(OUT + o) = v0; *(f32x4*)(OUT + o + 4) = v1;
                ss += (v0[0] * v0[0] + v0[1] * v0[1]) + (v0[2] * v0[2] + v0[3] * v0[3]) + (v1[0] * v1[0] + v1[1] * v1[1]) + (v1[2] * v1[2] + v1[3] * v1[3]); }
            ss += __shfl_xor(ss, 16); ss += __shfl_xor(ss, 32);
            if (fq == 0) SS2[r * 32 + u.pn * 4 + wc] = ss; }
    }
};
template <class Epi, class Sched, bool ALIGN_EPI = false, bool SP2 = false>
__device__ __forceinline__ void gemm_phase(PG8_LAS unsigned char* lds, const Gemm g, const Sched& S, const Epi& E, const int wid  ) {
    const int lane = lane_id(), tid = wid * 64 + lane, wr = wid >> 2, wc = wid & 3, fr = lane & 15, fq = lane >> 4;
    const int K = g.K, nt = K / BK;
    unsigned voffA[2], voffB[2];
#pragma unroll
    for (int i = 0; i < 2; ++i) { int R, C; stage_rc(tid * 16 + i * 8192, R, C); const int Rb = Epi::PERM ? ((R & ~31) + perm32(R & 31)) : R;
        voffA[i] = (unsigned)(R * g.lda + C) * 2u; voffB[i] = (unsigned)(Rb * g.ldb + C) * 2u; }
    const size_t kstep = (size_t)(BK * 2);
    const size_t hstepA = (size_t)HALF * g.lda * 2, hstepB = (size_t)HALF * g.ldb * 2;
    const size_t tstepA = 2 * hstepA, tstepB = 2 * hstepB;
    const unsigned ldsw = (unsigned)wid * 1024u;
    const int aoff = lds_byte(wr * 64 + fr, fq * 8), boff = lds_byte(wc * 32 + fr, fq * 8);
#define PG8_SA(b, h) (((b) * 2 + (h)) * HTB)
#define PG8_SB(b, h) ((4 + (b) * 2 + (h)) * HTB)
#define PG8_STAGE(bufoff, gbase, voff) do { _Pragma("unroll") for (int _i = 0; _i < 2; ++_i) \
        __builtin_amdgcn_global_load_lds((const unsigned*)((const char*)(gbase) + (voff)[_i]), (PG8_LAS unsigned*)(lds + (bufoff) + ldsw + _i * 8192), 16, 0, 0); } while (0)
#define PG8_LDA(dst, b, h) do { _Pragma("unroll") for (int m = 0; m < 4; ++m) _Pragma("unroll") for (int k = 0; k < 2; ++k) dst[m][k] = *(const PG8_LAS bf16x8*)(lds + PG8_SA(b, h) + aoff + m * 2048 + k * 1024); } while (0)
#define PG8_LDB(dst, b, h) do { _Pragma("unroll") for (int n = 0; n < 2; ++n) _Pragma("unroll") for (int k = 0; k < 2; ++k) dst[n][k] = *(const PG8_LAS bf16x8*)(lds + PG8_SB(b, h) + boff + n * 2048 + k * 1024); } while (0)
#define PG8_MMA(ai, bj, At, Bt) do { __builtin_amdgcn_s_setprio(1); _Pragma("unroll") for (int m = 0; m < 4; ++m) _Pragma("unroll") for (int n = 0; n < 2; ++n) _Pragma("unroll") for (int k = 0; k < 2; ++k) \
        acc[ai][bj][m][n] = __builtin_amdgcn_mfma_f32_16x16x32_bf16(Bt[n][k], At[m][k], acc[ai][bj][m][n], 0, 0, 0); __builtin_amdgcn_s_setprio(0); } while (0)
#define PG8_WAIT_V(n) asm volatile("s_waitcnt vmcnt(" #n ")" ::: "memory")
#define PG8_WAIT_L(n) asm volatile("s_waitcnt lgkmcnt(" #n ")" ::: "memory")
#define PG8_BAR __builtin_amdgcn_s_barrier()
#define PG8_SCHED __builtin_amdgcn_sched_barrier(0)
    Unit cur, nxt; int ui = 0;
    if (!S.next(0, cur)) return;
    f32x4 acc[2][2][4][2];
#pragma unroll
    for (int a = 0; a < 2; ++a)
#pragma unroll
        for (int b = 0; b < 2; ++b)
#pragma unroll
            for (int m = 0; m < 4; ++m)
#pragma unroll
                for (int n = 0; n < 2; ++n) acc[a][b][m][n] = (f32x4){0.f, 0.f, 0.f, 0.f};
    bf16x8 At[4][2], B0[2][2], B1[2][2];
    const char* cA = (const char*)g.A + (size_t)cur.pm * tstepA; const char* cB = (const char*)g.Bt + (size_t)cur.pn * tstepB;
    S.a_ready(cur);
    if constexpr (SP2) {
        PG8_STAGE(PG8_SB(0, 0), cB, voffB); PG8_STAGE(PG8_SB(0, 1), cB + hstepB, voffB); PG8_STAGE(PG8_SA(0, 0), cA, voffA); PG8_STAGE(PG8_SA(0, 1), cA + hstepA, voffA);
        if (wr == 1) PG8_BAR;
        PG8_WAIT_V(2); PG8_BAR;
        PG8_STAGE(PG8_SB(1, 0), cB + kstep, voffB); PG8_STAGE(PG8_SA(1, 0), cA + kstep, voffA); PG8_STAGE(PG8_SB(1, 1), cB + hstepB + kstep, voffB);
        PG8_WAIT_V(6); PG8_BAR;
    } else {
        PG8_STAGE(PG8_SB(0, 0), cB, voffB); PG8_STAGE(PG8_SA(0, 0), cA, voffA); PG8_STAGE(PG8_SB(0, 1), cB + hstepB, voffB); PG8_STAGE(PG8_SA(0, 1), cA + hstepA, voffA);
        if (wr == 1) PG8_BAR;
        PG8_WAIT_V(4); PG8_BAR;
        PG8_STAGE(PG8_SB(1, 0), cB + kstep, voffB); PG8_STAGE(PG8_SA(1, 0), cA + kstep, voffA); PG8_STAGE(PG8_SB(1, 1), cB + hstepB + kstep, voffB);
        PG8_WAIT_V(6); PG8_BAR;
    }
    for (;;) {
        const bool has_next = S.next(ui + 1, nxt);
        const char* nA = has_next ? (const char*)g.A + (size_t)nxt.pm * tstepA : cA; const char* nB = has_next ? (const char*)g.Bt + (size_t)nxt.pn * tstepB : cB;
        for (int t = 0; t < nt; t += 2) {
            const bool last = (t == nt - 2);
            const char* a1 = cA + (size_t)(t + 1) * kstep;
            const char* a2 = last ? nA : cA + (size_t)(t + 2) * kstep; const char* b2 = last ? nB : cB + (size_t)(t + 2) * kstep;
            const char* a3 = a2 + kstep; const char* b3 = b2 + kstep;
            if (last && has_next) S.a_ready(nxt);
            if constexpr (SP2) {
            PG8_LDB(B0, 0, 0); PG8_LDB(B1, 0, 1); PG8_SCHED; PG8_LDA(At, 0, 0); PG8_STAGE(PG8_SA(1, 1), a1 + hstepA, voffA);
            PG8_WAIT_V(8); PG8_WAIT_L(0); PG8_BAR; PG8_MMA(0, 0, At, B0); PG8_MMA(0, 1, At, B1); PG8_BAR; PG8_SCHED;
            PG8_LDA(At, 0, 1); PG8_STAGE(PG8_SB(0, 0), b2, voffB); PG8_STAGE(PG8_SB(0, 1), b2 + hstepB, voffB); PG8_STAGE(PG8_SA(0, 0), a2, voffA);
            PG8_WAIT_V(8); PG8_WAIT_L(0); PG8_BAR; PG8_MMA(1, 0, At, B0); PG8_MMA(1, 1, At, B1); PG8_BAR; PG8_SCHED;
            PG8_LDB(B0, 1, 0); PG8_LDB(B1, 1, 1); PG8_SCHED; PG8_LDA(At, 1, 0); PG8_STAGE(PG8_SA(0, 1), a2 + hstepA, voffA);
            PG8_WAIT_V(8); PG8_WAIT_L(0); PG8_BAR; PG8_MMA(0, 0, At, B0); PG8_MMA(0, 1, At, B1); PG8_BAR; PG8_SCHED;
            PG8_LDA(At, 1, 1); PG8_STAGE(PG8_SB(1, 0), b3, voffB); PG8_STAGE(PG8_SB(1, 1), b3 + hstepB, voffB); PG8_STAGE(PG8_SA(1, 0), a3, voffA);
            PG8_WAIT_V(8); PG8_WAIT_L(0); PG8_BAR; PG8_MMA(1, 0, At, B0); PG8_MMA(1, 1, At, B1); PG8_BAR; PG8_SCHED;
            } else {
            PG8_LDB(B0, 0, 0); PG8_SCHED; PG8_LDA(At, 0, 0); PG8_STAGE(PG8_SA(1, 1), a1 + hstepA, voffA);
            PG8_WAIT_L(8); PG8_BAR; PG8_WAIT_L(0); PG8_MMA(0, 0, At, B0); PG8_BAR; PG8_SCHED;
            PG8_LDB(B1, 0, 1); PG8_STAGE(PG8_SB(0, 0), b2, voffB);
            PG8_BAR; PG8_WAIT_L(0); PG8_MMA(0, 1, At, B1); PG8_BAR;
            PG8_LDA(At, 0, 1); PG8_STAGE(PG8_SA(0, 0), a2, voffA);
            PG8_BAR; PG8_WAIT_L(0); PG8_MMA(1, 0, At, B0); PG8_BAR; PG8_SCHED;
            PG8_STAGE(PG8_SB(0, 1), b2 + hstepB, voffB);
            PG8_WAIT_V(6); PG8_BAR; PG8_MMA(1, 1, At, B1); PG8_BAR;
            PG8_LDB(B0, 1, 0); PG8_SCHED; PG8_LDA(At, 1, 0); PG8_STAGE(PG8_SA(0, 1), a2 + hstepA, voffA);
            PG8_WAIT_L(8); PG8_BAR; PG8_WAIT_L(0); PG8_MMA(0, 0, At, B0); PG8_BAR; PG8_SCHED;
            PG8_LDB(B1, 1, 1); PG8_STAGE(PG8_SB(1, 0), b3, voffB);
            PG8_BAR; PG8_WAIT_L(0); PG8_MMA(0, 1, At, B1); PG8_BAR;
            PG8_LDA(At, 1, 1); PG8_STAGE(PG8_SA(1, 0), a3, voffA);
            PG8_BAR; PG8_WAIT_L(0); PG8_MMA(1, 0, At, B0); PG8_BAR; PG8_SCHED;
            PG8_STAGE(PG8_SB(1, 1), b3 + hstepB, voffB);
            PG8_WAIT_V(6); PG8_BAR; PG8_MMA(1, 1, At, B1); PG8_BAR;
            }
        }
        if constexpr (ALIGN_EPI) { if (wr == 0) PG8_BAR; }
        if constexpr (!Epi::AFTER_DRAIN) { E(acc, cur, wr, wc, fr, fq); S.done(cur); }
        if (!has_next) break;
#pragma unroll
        for (int a = 0; a < 2; ++a)
#pragma unroll
            for (int b = 0; b < 2; ++b)
#pragma unroll
                for (int m = 0; m < 4; ++m)
#pragma unroll
                    for (int n = 0; n < 2; ++n) acc[a][b][m][n] = (f32x4){0.f, 0.f, 0.f, 0.f};
        cur = nxt; cA = nA; cB = nB; ++ui;
        if constexpr (ALIGN_EPI) { if (wr == 1) PG8_BAR; }
    }
    PG8_WAIT_V(0);
    if constexpr (!ALIGN_EPI) { if (wr == 0) PG8_BAR; }
    PG8_BAR;
    if constexpr (Epi::AFTER_DRAIN) { E.fused(acc, cur, wr, wc, fr, fq, lds, wid, lane); S.done(cur); }
#undef PG8_SA
#undef PG8_SB
#undef PG8_STAGE
#undef PG8_LDA
#undef PG8_LDB
#undef PG8_MMA
#undef PG8_WAIT_V
#undef PG8_WAIT_L
#undef PG8_BAR
#undef PG8_SCHED
}
}
#include <hip/hip_bf16.h>
#include <cmath>
namespace attn_body {
using bf16=__hip_bfloat16;
using bf16x8=__attribute__((ext_vector_type(8)))short;
using s16x4=__attribute__((ext_vector_type(4)))short;
using f32x16=__attribute__((ext_vector_type(16)))float;
using u32x4=__attribute__((ext_vector_type(4)))unsigned;
using f32x4a=__attribute__((ext_vector_type(4)))float;
constexpr int BATCH=4,NHEAD=16,SEQ=4096,D=64,DM=4096;
constexpr int NW=8,QBLK=32,QB=QBLK*NW,KVBLK=64,NQB=SEQ/QB;
constexpr int ATTN_PITCH=DM, ATTN_UNIT_ROWS=QB;
__device__ __forceinline__ int crow(int r,int hi){return (r&3)+8*(r>>2)+4*hi;}
#define SBAR() __builtin_amdgcn_sched_barrier(0)
__device__ __forceinline__ void cmask(f32x16&p0,f32x16&p1,int jb,int qrel,int hi){
  const float NEG=-INFINITY; int kb=64*jb+4*hi;
  #pragma unroll
  for(int r=0;r<16;++r){int kv=kb+(r&3)+8*(r>>2); if(kv>qrel)p0[r]=NEG; if(kv+32>qrel)p1[r]=NEG;}
}

constexpr int NSLOT=3, SLOTB=8192;
constexpr int LDS_K=0, LDS_V=NSLOT*SLOTB, LDS_WS=2*NSLOT*SLOTB, LDS_OST=LDS_WS+NW*64*4, LDS_CB=LDS_OST+NW*4096, LDS_BYTES=LDS_CB+NW*768;
constexpr float C2=0.125f*1.4426950408889634f;
__device__ __forceinline__ void glds16(const void*gsrc,unsigned lds_dst){unsigned keep;
  asm volatile("s_mov_b32 %0, m0\n\ts_mov_b32 m0, %2\n\ts_nop 0\n\tglobal_load_lds_dwordx4 %1, off\n\ts_mov_b32 m0, %0":"=&s"(keep):"v"(gsrc),"s"(lds_dst):"memory");}
__device__ __forceinline__ void glds4(const void*gsrc,unsigned lds_dst){unsigned keep;
  asm volatile("s_mov_b32 %0, m0\n\ts_mov_b32 m0, %2\n\ts_nop 0\n\tglobal_load_lds_dword %1, off\n\ts_mov_b32 m0, %0":"=&s"(keep):"v"(gsrc),"s"(lds_dst):"memory");}
__device__ __forceinline__ float max3f(float a,float b,float c){float r;asm("v_max3_f32 %0, %1, %2, %3":"=v"(r):"v"(a),"v"(b),"v"(c));return r;}
__device__ __forceinline__ float max2f(float a,float b){float r;asm("v_max_f32_e32 %0, %1, %2":"=v"(r):"v"(a),"v"(b));return r;}
__device__ __forceinline__ float fadd_s(float a,float b){float r;asm("v_add_f32_e32 %0, %1, %2":"=v"(r):"v"(a),"v"(b));return r;}
__device__ __forceinline__ float fsub_s(float a,float b){float r;asm("v_sub_f32_e32 %0, %1, %2":"=v"(r):"v"(a),"v"(b));return r;}
typedef float f32x2_t __attribute__((ext_vector_type(2))); typedef __bf16 bf16x2_t __attribute__((ext_vector_type(2)));
__device__ __forceinline__ unsigned cvtpk_s(float lo,float hi){f32x2_t v={lo,hi};bf16x2_t b=__builtin_convertvector(v,bf16x2_t);return __builtin_bit_cast(unsigned,b);}
#define WAIT_BAR(N) asm volatile("s_waitcnt vmcnt(" #N ") lgkmcnt(0)\n\ts_barrier":::"memory")

__device__ __forceinline__ void qkt(f32x16&p0,f32x16&p1,const char*Kslot,const bf16x8*qr,int r32,int hi){
  const char*kb=Kslot+hi*1024+r32*16;
  #pragma unroll
  for(int d0=0;d0<4;++d0){
    const bf16x8 b0=*reinterpret_cast<const bf16x8*>(kb+d0*2048);
    const bf16x8 b1=*reinterpret_cast<const bf16x8*>(kb+d0*2048+512);
    p0=__builtin_amdgcn_mfma_f32_32x32x16_bf16(b0,qr[d0],p0,0,0,0);p1=__builtin_amdgcn_mfma_f32_32x32x16_bf16(b1,qr[d0],p1,0,0,0);}
}
typedef __attribute__((address_space(3))) const char* lds_cptr;
typedef short v4i16_t __attribute__((ext_vector_type(4)));
__device__ __forceinline__ void kload8(bf16x8*kf,lds_cptr kp){
  kf[0]=*(const __attribute__((address_space(3))) bf16x8*)(kp);      kf[1]=*(const __attribute__((address_space(3))) bf16x8*)(kp+512);
  kf[2]=*(const __attribute__((address_space(3))) bf16x8*)(kp+2048); kf[3]=*(const __attribute__((address_space(3))) bf16x8*)(kp+2560);
  kf[4]=*(const __attribute__((address_space(3))) bf16x8*)(kp+4096); kf[5]=*(const __attribute__((address_space(3))) bf16x8*)(kp+4608);
  kf[6]=*(const __attribute__((address_space(3))) bf16x8*)(kp+6144); kf[7]=*(const __attribute__((address_space(3))) bf16x8*)(kp+6656);
}
__device__ __forceinline__ void kload2(bf16x8*kf,lds_cptr kp,int j){ kf[2*j]=*(const __attribute__((address_space(3))) bf16x8*)(kp+j*2048); kf[2*j+1]=*(const __attribute__((address_space(3))) bf16x8*)(kp+j*2048+512); }
__device__ __forceinline__ s16x4 vtr(lds_cptr p){ return __builtin_bit_cast(s16x4,__builtin_amdgcn_ds_read_tr16_b64_v4i16((__attribute__((address_space(3))) v4i16_t*)p)); }
__device__ __forceinline__ float rowmax(const f32x16&p0,const f32x16&p1){
  float a=max3f(p0[0],p0[1],p1[0]),b=max3f(p0[2],p0[3],p1[1]);a=max3f(a,p1[2],p1[3]);
  #pragma unroll
  for(int r=4;r<16;r+=4){a=max3f(a,p0[r],p0[r+1]);b=max3f(b,p0[r+2],p0[r+3]);a=max3f(a,p1[r],p1[r+1]);b=max3f(b,p1[r+2],p1[r+3]);}
  const float m=max2f(a,b);
  auto rr=__builtin_amdgcn_permlane32_swap(__float_as_uint(m),__float_as_uint(m),false,false);
  return max2f(__uint_as_float(rr[0]),__uint_as_float(rr[1]));
}
__device__ __forceinline__ void pv(f32x16*o,int vb,bf16x8 pa0,bf16x8 pa1,bf16x8 pa2,bf16x8 pa3){
  #pragma unroll
  for(int d0=0;d0<2;++d0){s16x4 lo[4],hi[4];
    #pragma unroll
    for(int ks=0;ks<4;++ks){
      asm volatile("ds_read_b64_tr_b16 %0,%1 offset:%c2":"=&v"(lo[ks]):"v"(vb),"i"(d0*4096+ks*1024):"memory");
      asm volatile("ds_read_b64_tr_b16 %0,%1 offset:%c2":"=&v"(hi[ks]):"v"(vb),"i"(d0*4096+ks*1024+512):"memory");}
    asm volatile("s_waitcnt lgkmcnt(0)":::"memory");SBAR();
    #define PK(k) (bf16x8){lo[k][0],lo[k][1],lo[k][2],lo[k][3],hi[k][0],hi[k][1],hi[k][2],hi[k][3]}
    o[d0]=__builtin_amdgcn_mfma_f32_32x32x16_bf16(pa0,PK(0),o[d0],0,0,0);
    o[d0]=__builtin_amdgcn_mfma_f32_32x32x16_bf16(pa1,PK(1),o[d0],0,0,0);
    o[d0]=__builtin_amdgcn_mfma_f32_32x32x16_bf16(pa2,PK(2),o[d0],0,0,0);
    o[d0]=__builtin_amdgcn_mfma_f32_32x32x16_bf16(pa3,PK(3),o[d0],0,0,0);
    #undef PK
  }
}

#ifndef ATTN_STORE16
#define ATTN_STORE16(p,v) (*(u32x4*)(p)=(v))
#endif
template<int THRL> __device__ __forceinline__ void attn_unit(int b,int h,int qb,const bf16*Q,const bf16*__restrict__ K,const bf16*__restrict__ V,const bf16*__restrict__ G,const float*__restrict__ CF,bf16*O,char*shm,const int wid){
  const int lane=lane_id(),r32=lane&31,hi=lane>>5;
  const long rowbase=(long)b*SEQ; const int q0=qb*QB;
  const bf16*Qw=Q+(rowbase+q0+wid*QBLK)*DM+h*D;
  const bf16*Kh=K+rowbase*DM+h*D,*Vh=V+rowbase*DM+h*D; const float*CFh=CF+(long)(b*NHEAD+h)*SEQ;
  const unsigned lds0=(unsigned)(uintptr_t)shm;
  float*wsf=(float*)(shm+LDS_WS)+wid*64;
  const bf16*ksrc=Kh+(long)lane*DM+wid*8;
  const bf16*vsrc=Vh+(long)(16*(wid&3)+(lane>>2))*DM+(wid>>2)*32+(lane&3)*8;
  const unsigned kdst=lds0+LDS_K+wid*1024, vdst=lds0+LDS_V+wid*1024, cdst=lds0+LDS_CB+wid*768; const float*csrc=CFh+lane;
  #define DMA_K(t,slot) do{ glds16(ksrc+(long)(t)*KVBLK*DM,(unsigned)__builtin_amdgcn_readfirstlane(kdst+(slot))); glds4(csrc+(t)*KVBLK,(unsigned)__builtin_amdgcn_readfirstlane(cdst+((slot)>>5))); }while(0)
  #define DMA_V(t,slot) glds16(vsrc+(long)(t)*KVBLK*DM,(unsigned)__builtin_amdgcn_readfirstlane(vdst+(slot)))
  const int vb0=(int)(lds0+LDS_V)+((lane>>4)&1)*32+(lane&3)*8+(4*hi+((lane&15)>>2))*64;
  const char*Kbase=shm+LDS_K; bf16x8 kf[8];
  const lds_cptr shm3=(lds_cptr)shm; const lds_cptr kp0=shm3+LDS_K+hi*1024+r32*16; const lds_cptr vp0=shm3+LDS_V+((lane>>4)&1)*32+(lane&3)*8+(4*hi+((lane&15)>>2))*64;
  const int NT=(q0+QB)/KVBLK;
  DMA_K(0,0);DMA_V(0,0);DMA_K(1,SLOTB);
  bf16x8 qr[4];
  #pragma unroll
  for(int d0=0;d0<4;++d0)qr[d0]=*reinterpret_cast<const bf16x8*>(&Qw[(long)r32*DM+d0*16+hi*8]);
  float mhat=0.f,l_reg=0.f;f32x16 o[2];o[0]=f32x16{};o[1]=f32x16{};
  float nb=CFh[q0+wid*QBLK+r32];
  const lds_cptr cbp0=(lds_cptr)shm+LDS_CB+wid*768+hi*16;
  #define CINIT(C0,C1,slot) do{ const lds_cptr cb_=cbp0+((slot)>>5); _Pragma("unroll") for(int g_=0;g_<4;++g_){ \
      const f32x4a a_=*(const __attribute__((address_space(3))) f32x4a*)(cb_+32*g_), b_=*(const __attribute__((address_space(3))) f32x4a*)(cb_+128+32*g_); \
      _Pragma("unroll") for(int i_=0;i_<4;++i_){ C0[4*g_+i_]=nb-a_[i_]; C1[4*g_+i_]=nb-b_[i_]; } } }while(0)
  const int qrel=wid*QBLK+r32;
  #define CMASK(P0,P1,t) do{int jb_=(t)-(NT-4); if(jb_>=0)cmask(P0,P1,jb_,qrel,hi);}while(0)
  bool resc=false;
  #define START(P0,P1) do{ const float rm=rowmax(P0,P1); resc=false; \
    { const float dl=rm; mhat=fadd_s(mhat,dl); \
      _Pragma("unroll") for(int r=0;r<16;++r){P0[r]=fsub_s(P0[r],dl);P1[r]=fsub_s(P1[r],dl);} \
      nb-=dl; } \
    _Pragma("unroll") for(int r=0;r<16;++r)P0[r]=__builtin_amdgcn_exp2f(P0[r]); }while(0)
  #define RESC() do{ if(resc){ asm volatile("s_waitcnt lgkmcnt(0)":::"memory"); \
      _Pragma("unroll") for(int d_=0;d_<2;++d_) _Pragma("unroll") for(int r=0;r<16;++r)o[d_][r]*=wsf[crow(r,hi)]; } }while(0)
  f32x16 pA0,pA1,pB0,pB1;
  int sl_prev=0,sl_cur=0,sl_next=SLOTB;
  #define ROT() do{sl_prev=sl_cur;sl_cur=sl_next;sl_next=(sl_next==(NSLOT-1)*SLOTB)?0:sl_next+SLOTB;}while(0)
  DMA_K(2,2*SLOTB);
  WAIT_BAR(3);
  CINIT(pA0,pA1,0); qkt(pA0,pA1,Kbase,qr,r32,hi);asm volatile("s_nop 15\n\ts_nop 7":"+v"(pA0),"+v"(pA1));CMASK(pA0,pA1,0);
  START(pA0,pA1);
  _Pragma("unroll") for(int r=0;r<16;++r)pA1[r]=__builtin_amdgcn_exp2f(pA1[r]);
  WAIT_BAR(0);
  DMA_K(3,0);DMA_V(1,SLOTB);
  ROT();
  kload8(kf,kp0+sl_cur);
  WAIT_BAR(3);
  s16x4 vlo[8],vhi[8]; u32x4 pw0,pw1,pw2,pw3;
  #define PKW(P,B) cvtpk_s(P[B],P[B+1])
  #define PAF(k) __builtin_bit_cast(bf16x8,pw##k)
  #define VFR(i) (bf16x8){vlo[i][0],vlo[i][1],vlo[i][2],vlo[i][3],vhi[i][0],vhi[i][1],vhi[i][2],vhi[i][3]}
  #define PIN(x) asm volatile("":"+v"(x))
  #define MX3(a,b,c) __builtin_fmaxf(__builtin_fmaxf((a),(b)),(c))
  #define GAPA(MF,A0,A1,A2,A3,W0,W1,PW) do{ MF; sacc+=A0; sacc+=A1; sacc+=A2; sacc+=A3; PIN(sacc); W0; W1; PIN(PW); SBAR(); }while(0)
  #define EX(v) __builtin_amdgcn_exp2f(v)
  #define GAPB(MF,X,B) do{ MF; X[B]=EX(X[B]); X[B+1]=EX(X[B+1]); X[B+2]=EX(X[B+2]); X[B+3]=EX(X[B+3]); PIN(X); SBAR(); }while(0)
  #define VRD(i) do{ vlo[i]=vtr(vp_+(((i)>>2)*4096+((i)&3)*1024)); vhi[i]=vtr(vp_+(((i)>>2)*4096+((i)&3)*1024+512)); }while(0)
  #define KRD(G,j) do{ if(G){ kload2(kf,kp0+sl_next,j); SBAR(); } }while(0)
  #define STEP(C0,C1,P0,P1,t,GK,GV,GL) do{ SBAR(); \
    CINIT(C0,C1,sl_cur); SBAR(); \
    const lds_cptr vp_=vp0+sl_prev; \
    VRD(0); SBAR(); float sacc=(P0[0]+P0[1]); \
    GAPA(C0=__builtin_amdgcn_mfma_f32_32x32x16_bf16(kf[0],qr[0],C0,0,0,0), P0[2],P0[3],P0[4],P0[5],     pw0[0]=PKW(P0,0), pw0[1]=PKW(P0,2), pw0); \
    VRD(4); SBAR(); GAPA(C1=__builtin_amdgcn_mfma_f32_32x32x16_bf16(kf[1],qr[0],C1,0,0,0), P0[6],P0[7],P0[8],P0[9],     pw0[2]=PKW(P0,4), pw0[3]=PKW(P0,6), pw0); \
    VRD(1); SBAR(); GAPA(C0=__builtin_amdgcn_mfma_f32_32x32x16_bf16(kf[2],qr[1],C0,0,0,0),   P0[10],P0[11],P0[12],P0[13], pw1[0]=PKW(P0,8), pw1[1]=PKW(P0,10), pw1); \
    VRD(5); SBAR(); GAPA(C1=__builtin_amdgcn_mfma_f32_32x32x16_bf16(kf[3],qr[1],C1,0,0,0),   P0[14],P0[15],P1[0],P1[1],   pw1[2]=PKW(P0,12),pw1[3]=PKW(P0,14), pw1); \
    VRD(2); SBAR(); GAPA(C0=__builtin_amdgcn_mfma_f32_32x32x16_bf16(kf[4],qr[2],C0,0,0,0),   P1[2],P1[3],P1[4],P1[5],     pw2[0]=PKW(P1,0), pw2[1]=PKW(P1,2), pw2); \
    VRD(6); SBAR(); GAPA(C1=__builtin_amdgcn_mfma_f32_32x32x16_bf16(kf[5],qr[2],C1,0,0,0),   P1[6],P1[7],P1[8],P1[9],     pw2[2]=PKW(P1,4), pw2[3]=PKW(P1,6), pw2); \
    VRD(3); SBAR(); GAPA(C0=__builtin_amdgcn_mfma_f32_32x32x16_bf16(kf[6],qr[3],C0,0,0,0),   P1[10],P1[11],P1[12],P1[13], pw3[0]=PKW(P1,8), pw3[1]=PKW(P1,10), pw3); \
    VRD(7); SBAR(); GAPA(C1=__builtin_amdgcn_mfma_f32_32x32x16_bf16(kf[7],qr[3],C1,0,0,0),   P1[14],P1[15],0.f,0.f,       pw3[2]=PKW(P1,12),pw3[3]=PKW(P1,14), pw3); \
    l_reg+=sacc; \
    if(GK){DMA_K((t)+3,sl_cur);} if(GV){DMA_V((t)+1,sl_next);} \
    CMASK(C0,C1,t); \
    { float a=MX3(C0[0],C0[1],C1[0]),b=MX3(C0[2],C0[3],C1[1]); a=MX3(a,C1[2],C1[3]); \
      _Pragma("unroll") for(int r=4;r<16;r+=4){a=MX3(a,C0[r],C0[r+1]);b=MX3(b,C0[r+2],C0[r+3]);a=MX3(a,C1[r],C1[r+1]);b=MX3(b,C1[r+2],C1[r+3]);} \
      float rm=__builtin_fmaxf(a,b); { auto rr=__builtin_amdgcn_permlane32_swap(__float_as_uint(rm),__float_as_uint(rm),false,false); rm=__builtin_fmaxf(__uint_as_float(rr[0]),__uint_as_float(rr[1])); } \
      resc=false; \
      if(__builtin_expect(__any(rm>(float)THRL),0)){ const float dl=__builtin_fmaxf(rm,0.f); mhat+=dl; \
        _Pragma("unroll") for(int r=0;r<16;++r){C0[r]-=dl;C1[r]-=dl;} \
        nb-=dl; \
        const float f=__builtin_amdgcn_exp2f(-dl); l_reg*=f; if(hi==0)wsf[r32]=f; resc=true; } } \
    SBAR(); \
    GAPB(o[0]=__builtin_amdgcn_mfma_f32_32x32x16_bf16(PAF(0),VFR(0),o[0],0,0,0), C0,0); \
    GAPB(o[1]=__builtin_amdgcn_mfma_f32_32x32x16_bf16(PAF(0),VFR(4),o[1],0,0,0), C0,4); \
    KRD(GL,0); GAPB(o[0]=__builtin_amdgcn_mfma_f32_32x32x16_bf16(PAF(1),VFR(1),o[0],0,0,0), C0,8); \
    KRD(GL,1); GAPB(o[1]=__builtin_amdgcn_mfma_f32_32x32x16_bf16(PAF(1),VFR(5),o[1],0,0,0), C0,12); \
    KRD(GL,2); GAPB(o[0]=__builtin_amdgcn_mfma_f32_32x32x16_bf16(PAF(2),VFR(2),o[0],0,0,0), C1,0); \
    KRD(GL,3); GAPB(o[1]=__builtin_amdgcn_mfma_f32_32x32x16_bf16(PAF(2),VFR(6),o[1],0,0,0), C1,4); \
    GAPB(o[0]=__builtin_amdgcn_mfma_f32_32x32x16_bf16(PAF(3),VFR(3),o[0],0,0,0), C1,8); \
    GAPB(o[1]=__builtin_amdgcn_mfma_f32_32x32x16_bf16(PAF(3),VFR(7),o[1],0,0,0), C1,12); \
    }while(0)
  int t=1;
  #undef CMASK
  #define CMASK(P0,P1,t) do{}while(0)
  for(;t+5<NT;t+=2){
    STEP(pB0,pB1,pA0,pA1,t,true,true,true);     WAIT_BAR(3); RESC(); ROT();
    STEP(pA0,pA1,pB0,pB1,t+1,true,true,true);   WAIT_BAR(3); RESC(); ROT();
  }
  #undef CMASK
  #define CMASK(P0,P1,t) do{int jb_=(t)-(NT-4); if(jb_>=0)cmask(P0,P1,jb_,qrel,hi);}while(0)
  #define ENDW(tt) do{ if((tt)+3<NT){WAIT_BAR(3);} else if((tt)+2<NT){WAIT_BAR(1);} else {WAIT_BAR(0);} }while(0)
  for(;t+1<NT;t+=2){
    STEP(pB0,pB1,pA0,pA1,t,(t+3<NT),(t+1<NT),(t+1<NT));       ENDW(t);   RESC(); ROT();
    STEP(pA0,pA1,pB0,pB1,t+1,(t+4<NT),(t+2<NT),(t+2<NT));     ENDW(t+1); RESC(); ROT();
  }
  STEP(pB0,pB1,pA0,pA1,NT-1,false,false,false); RESC();
  { float sacc=pB0[0]+pB0[1]; _Pragma("unroll") for(int r=2;r<16;++r)sacc+=pB0[r]; _Pragma("unroll") for(int r=0;r<16;++r)sacc+=pB1[r]; l_reg+=sacc;
    pw0=(u32x4){PKW(pB0,0),PKW(pB0,2),PKW(pB0,4),PKW(pB0,6)};pw1=(u32x4){PKW(pB0,8),PKW(pB0,10),PKW(pB0,12),PKW(pB0,14)};pw2=(u32x4){PKW(pB1,0),PKW(pB1,2),PKW(pB1,4),PKW(pB1,6)};pw3=(u32x4){PKW(pB1,8),PKW(pB1,10),PKW(pB1,12),PKW(pB1,14)};
    SBAR(); pv(o,vb0+sl_cur,PAF(0),PAF(1),PAF(2),PAF(3)); }
  #undef PKW
  #undef PAF
  #undef VFR
  #undef PIN
  #undef MX3
  #undef GAPA
  #undef GAPB
  #undef EX
  #undef VRD
  #undef KRD
  #undef STEP
  #undef ENDW
  {auto rr=__builtin_amdgcn_permlane32_swap(__float_as_uint(l_reg),__float_as_uint(l_reg),false,false);l_reg=__uint_as_float(rr[0])+__uint_as_float(rr[1]);}
  if(hi==0)wsf[32+r32]=l_reg;asm volatile("s_waitcnt lgkmcnt(0)":::"memory");
  float rli[16];
  #pragma unroll
  for(int r=0;r<16;++r)rli[r]=__builtin_amdgcn_rcpf(wsf[32+crow(r,hi)]);
  bf16*Ow=O+(rowbase+q0+wid*QBLK)*DM+h*D;
  { bf16*stg=(bf16*)(shm+LDS_OST)+wid*2048;
    #pragma unroll
    for(int r=0;r<16;++r){const int orow=crow(r,hi);
      #pragma unroll
      for(int d0=0;d0<2;++d0)stg[orow*64+d0*32+r32]=__float2bfloat16(o[d0][r]*rli[r]);}
    asm volatile("s_waitcnt lgkmcnt(0)":::"memory");
    const bf16*Gw=G+(rowbase+q0+wid*QBLK)*DM+h*D;
    #pragma unroll
    for(int i=0;i<4;++i){const int row=i*8+(lane>>3),ch=lane&7; const u32x4 v=*(const u32x4*)(stg+row*64+ch*8); const u32x4 gv=*(const u32x4*)(Gw+(long)row*DM+ch*8); u32x4 w;
      #pragma unroll
      for(int e=0;e<4;++e){ const float o0=__uint_as_float(v[e]<<16),o1=__uint_as_float(v[e]&0xffff0000u),g0=__uint_as_float(gv[e]<<16),g1=__uint_as_float(gv[e]&0xffff0000u);
        const float s0=g0*__builtin_amdgcn_rcpf(1.f+__builtin_amdgcn_exp2f(-1.4426950408889634f*g0)),s1=g1*__builtin_amdgcn_rcpf(1.f+__builtin_amdgcn_exp2f(-1.4426950408889634f*g1)); w[e]=cvtpk_s(o0*s0,o1*s1); }
      ATTN_STORE16(Ow+(long)row*DM+ch*8,w);} }
  asm volatile("s_waitcnt lgkmcnt(0)\n\ts_barrier":::"memory");
  #undef DMA_K
  #undef CINIT
  #undef DMA_V
  #undef CMASK
  #undef START
  #undef RESC
  #undef ROT
}
constexpr int ATTN_LDS_BYTES=LDS_BYTES;
#undef SBAR
#undef WAIT_BAR
}
namespace scan {
#define SC_LAS __attribute__((address_space(3)))
typedef float f32x4 __attribute__((ext_vector_type(4)));
typedef float f32x2 __attribute__((ext_vector_type(2)));
typedef unsigned u32x2 __attribute__((ext_vector_type(2)));
constexpr int T = 4096, CH = 32, NCH = T / CH, STEPB = 1808, BUFB = CH * STEPB, YOFF = 2 * BUFB, LDS_BYTES = YOFF + CH * 256;
constexpr int O_W = 0, O_KK = 256, O_B = 512, O_KP = 768, O_WR = 1024, O_V = 1280, O_SG = 1536, O_SC = 1792;
template <int CTRL> __device__ __forceinline__ float dppf(float x) { return __builtin_bit_cast(float, __builtin_amdgcn_mov_dpp(__builtin_bit_cast(int, x), CTRL, 0xF, 0xF, true)); }
__device__ __forceinline__ float red16(float x) { x += dppf<0xB1>(x); x += dppf<0x4E>(x); x += dppf<0x141>(x); x += dppf<0x140>(x); return x; }
__device__ __forceinline__ f32x4 bf4(u32x2 u) { return (f32x4){__uint_as_float(u.x << 16), __uint_as_float(u.x & 0xffff0000u), __uint_as_float(u.y << 16), __uint_as_float(u.y & 0xffff0000u)}; }
__device__ __forceinline__ float dot4(f32x4 a, f32x4 b) { return (a.x * b.x + a.y * b.y) + (a.z * b.z + a.w * b.w); }
__device__ __forceinline__ unsigned pkbf(float lo, float hi) { typedef __bf16 b2 __attribute__((ext_vector_type(2))); f32x2 v = {lo, hi}; return __builtin_bit_cast(unsigned, __builtin_convertvector(v, b2)); }
struct Params { const unsigned short* ZRW; const float* DEC; const unsigned short* AG; unsigned short* YR; const float* mu; const float* k_k; const float* k_a; const float* r_k; const float* ln_g; const float* ln_b; };

__device__ __forceinline__ void scan_head(SC_LAS unsigned char* lds, const Params& P, int bh, const int wid) {
    const int lane = lane_id(), tid = wid * 64 + lane;
    const int b = bh >> 4, h = bh & 15, tl = tid >> 4, c4 = tid & 15, colh = h * 64 + 4 * c4;
    const f32x4 mu_r = *(const f32x4*)(P.mu + colh), mu_k = *(const f32x4*)(P.mu + 1024 + colh), mu_v = *(const f32x4*)(P.mu + 2048 + colh), mu_g = *(const f32x4*)(P.mu + 3072 + colh);
    const f32x4 kkc = *(const f32x4*)(P.k_k + colh), kac = *(const f32x4*)(P.k_a + colh), rkc = *(const f32x4*)(P.r_k + colh), lng = *(const f32x4*)(P.ln_g + colh), lnb = *(const f32x4*)(P.ln_b + colh);
    const int r0 = 8 * wid + 2 * (lane >> 4);
    f32x4 S0 = {0.f, 0.f, 0.f, 0.f}, S1 = {0.f, 0.f, 0.f, 0.f};
    u32x2 zr, zk, zv, zg, pr, pk, pv, pg, ag; f32x4 dec;
#define SC_LOAD(c) do { const int t_ = (c) * CH + tl; const size_t m_ = (size_t)b * T + t_; const unsigned short* z_ = P.ZRW + m_ * 4096 + colh; \
        zr = *(const u32x2*)(z_); zk = *(const u32x2*)(z_ + 1024); zv = *(const u32x2*)(z_ + 2048); zg = *(const u32x2*)(z_ + 3072); \
        if (t_ > 0) { pr = *(const u32x2*)(z_ - 4096); pk = *(const u32x2*)(z_ - 4096 + 1024); pv = *(const u32x2*)(z_ - 4096 + 2048); pg = *(const u32x2*)(z_ - 4096 + 3072); } \
        else { pr = (u32x2){0u, 0u}; pk = pr; pv = pr; pg = pr; } \
        dec = *(const f32x4*)(P.DEC + m_ * 1024 + colh); ag = *(const u32x2*)(P.AG + m_ * 1024 + colh); } while (0)
#define SC_PRODUCE(bo) do { SC_LAS unsigned char* base_ = lds + (bo) + tl * STEPB; \
        const f32x4 r_ = bf4(zr), k_ = bf4(zk), v_ = bf4(zv), g_ = bf4(zg); \
        const f32x4 rs = r_ + (bf4(pr) - r_) * mu_r, ks = k_ + (bf4(pk) - k_) * mu_k, vs = v_ + (bf4(pv) - v_) * mu_v, gs = g_ + (bf4(pg) - g_) * mu_g; \
        const f32x4 kkr = ks * kkc; const float n2 = red16(dot4(kkr, kkr)); const float inv = 1.f / fmaxf(sqrtf(n2), 1e-12f); const f32x4 kk = kkr * inv; \
        const f32x4 a_ = bf4(ag), kp = ks * (1.f + (a_ - 1.f) * kac), bv = kk * a_, wrv = dec * rs; \
        const float br = red16(dot4(bv, rs)), kr = red16(dot4(kp, rs)), kb = red16(dot4(rs * kp, rkc)); \
        f32x4 sg; _Pragma("unroll") for (int e = 0; e < 4; ++e) sg[e] = gs[e] * __builtin_amdgcn_rcpf(1.f + __builtin_amdgcn_exp2f(-1.4426950408889634f * gs[e])); \
        *(SC_LAS f32x4*)(base_ + O_W + c4 * 16) = dec; *(SC_LAS f32x4*)(base_ + O_KK + c4 * 16) = kk; *(SC_LAS f32x4*)(base_ + O_B + c4 * 16) = bv; *(SC_LAS f32x4*)(base_ + O_KP + c4 * 16) = kp; \
        *(SC_LAS f32x4*)(base_ + O_WR + c4 * 16) = wrv; *(SC_LAS f32x4*)(base_ + O_V + c4 * 16) = vs; *(SC_LAS f32x4*)(base_ + O_SG + c4 * 16) = sg; \
        if (c4 == 0) *(SC_LAS f32x4*)(base_ + O_SC) = (f32x4){br, kr, kb, 0.f}; } while (0)
    SC_LOAD(0); SC_PRODUCE(0); __syncthreads();
    for (int c = 0; c < NCH; ++c) {
        const int bo = (c & 1) * BUFB;
        if (c + 1 < NCH) SC_LOAD(c + 1);
        float ya = 0.f, yb = 0.f;
#pragma unroll 1
        for (int q = 0; q < CH / 4; ++q) {
            const SC_LAS unsigned char* cb = lds + bo + q * 4 * STEPB; const int cs = c4 - 4 * (q & 3);
#pragma unroll
            for (int s = 0; s < 4; ++s) {
                const SC_LAS unsigned char* p = cb + s * STEPB;
                const f32x4 W = *(const SC_LAS f32x4*)(p + O_W + c4 * 16), KK = *(const SC_LAS f32x4*)(p + O_KK + c4 * 16), B = *(const SC_LAS f32x4*)(p + O_B + c4 * 16);
                const f32x4 KP = *(const SC_LAS f32x4*)(p + O_KP + c4 * 16), WR = *(const SC_LAS f32x4*)(p + O_WR + c4 * 16);
                const f32x2 v2 = *(const SC_LAS f32x2*)(p + O_V + r0 * 4), sc = *(const SC_LAS f32x2*)(p + O_SC);
                const float sa0 = red16(dot4(S0, KK)), sa1 = red16(dot4(S1, KK)), y0 = red16(dot4(S0, WR)), y1 = red16(dot4(S1, WR));
                const float yo0 = y0 - sa0 * sc.x + v2.x * sc.y, yo1 = y1 - sa1 * sc.x + v2.y * sc.y;
                S0 = S0 * W + (v2.x * KP - sa0 * B); S1 = S1 * W + (v2.y * KP - sa1 * B);
                if (cs == s) { ya = yo0; yb = yo1; }
            }
            if ((q & 3) == 3) *(SC_LAS f32x2*)(lds + YOFF + ((q >> 2) * 16 + c4) * 256 + r0 * 4) = (f32x2){ya, yb};
        }
        __syncthreads();
        {
            const SC_LAS unsigned char* base_ = lds + bo + tl * STEPB;
            const f32x4 y4 = *(const SC_LAS f32x4*)(lds + YOFF + tl * 256 + c4 * 16);
            const float mean = red16((y4.x + y4.y) + (y4.z + y4.w)) * (1.f / 64.f); const f32x4 d = y4 - mean;
            const float var = red16(dot4(d, d)) * (1.f / 64.f); const float rs_ = __builtin_amdgcn_rsqf(var + 64e-5f);
            const f32x4 v4 = *(const SC_LAS f32x4*)(base_ + O_V + c4 * 16), sg4 = *(const SC_LAS f32x4*)(base_ + O_SG + c4 * 16); const float kb = *(const SC_LAS float*)(base_ + O_SC + 8);
            const f32x4 o = ((d * rs_) * lng + lnb + kb * v4) * sg4;
            const size_t m_ = (size_t)b * T + c * CH + tl;
            *(u32x2*)(P.YR + m_ * 1024 + colh) = (u32x2){pkbf(o.x, o.y), pkbf(o.z, o.w)};
        }
        if (c + 1 < NCH) SC_PRODUCE(((c + 1) & 1) * BUFB);
        __syncthreads();
    }
#undef SC_LOAD
#undef SC_PRODUCE
}
}
#include <hip/hip_cooperative_groups.h>
namespace cg = cooperative_groups;
#ifndef MK_PER_PHASE_LAUNCHES
#define MK_PER_PHASE_LAUNCHES 1
#endif
constexpr int NWAVES = 8, NTHREADS = NWAVES * 64;
constexpr int BATCH = 4, T = 4096, D = 2048, M = BATCH * T, C = 1024, H = 16, PLE = 256;
constexpr int N_IN = 12432, NZ = 12544;
constexpr float NORM_EPS = 1e-6f;
constexpr size_t MiB = 1u << 20;
constexpr size_t WS_CTL = 0, CTL_ZERO_BYTES = 32768;
constexpr int CW_BAR = 1024;
constexpr size_t WS_WIN = 1 * MiB, WS_WUPR = 50 * MiB, WS_WUPF = 54 * MiB, WS_WO = 58 * MiB, WS_WGATE = 66 * MiB, WS_WPLE = 74 * MiB, WS_WLORA = 75 * MiB;
constexpr size_t WS_ZRW = 76 * MiB, WS_ZFX = 204 * MiB, WS_ZG = 332 * MiB, WS_ZS = 460 * MiB, WS_LA = 476 * MiB, WS_PB = 484 * MiB, WS_CF = 492 * MiB, WS_SS1 = 493 * MiB, WS_SS2 = 495 * MiB, WS_END = 497 * MiB;
constexpr size_t WS_T1 = WS_ZRW, WS_MG = WS_ZRW + 64 * MiB;
constexpr size_t WS_X1 = WS_ZFX, WS_X1B = WS_ZG, WS_PLE = WS_ZG + 64 * MiB;
constexpr size_t OUT_H = 0, OUT_DEC = 0, OUT_AG = 64 * MiB, OUT_YR = 96 * MiB;
static_assert(WS_WIN + (size_t)NZ * D * 2 <= WS_WUPR && WS_ZS + (size_t)M * 256 * 4 <= WS_LA && WS_CF + (size_t)BATCH * H * T * 4 <= WS_SS1 && WS_SS1 + (size_t)M * 32 * 4 <= WS_SS2, "d_ws map");
constexpr int RING_BYTES = 131072, MISC_OFF = RING_BYTES, LDS_BYTES = 147456;
static_assert(WS_ZFX - WS_ZRW == WS_ZG - WS_ZFX, "EpiZ segment stride");
static_assert(scan::LDS_BYTES <= RING_BYTES && attn_body::ATTN_LDS_BYTES <= RING_BYTES, "phase scratch fits the ring region");

#define GAS __attribute__((address_space(1)))
#define LAS __attribute__((address_space(3)))
typedef unsigned short bf16;
typedef unsigned v4u __attribute__((ext_vector_type(4)));
typedef unsigned v2u __attribute__((ext_vector_type(2)));
typedef float f32x4 __attribute__((ext_vector_type(4)));
__device__ __forceinline__ unsigned f2bf(float f) { unsigned u = __builtin_bit_cast(unsigned, f); return (u + 0x7fffu + ((u >> 16) & 1u)) >> 16; }
__device__ __forceinline__ unsigned pk2(float lo, float hi) { return f2bf(lo) | (f2bf(hi) << 16); }
__device__ __forceinline__ float wave_sum(float v) {
#pragma unroll
    for (int o = 1; o < 64; o <<= 1) v += __shfl_xor(v, o);
    return v;
}
#define RLX_AGENT __ATOMIC_RELAXED, __HIP_MEMORY_SCOPE_AGENT
#define LDS_WAIT() asm volatile("s_waitcnt lgkmcnt(0)" ::: "memory")
#define VM_WAIT() asm volatile("s_waitcnt vmcnt(0)" ::: "memory")
__device__ __forceinline__ unsigned long long rt() { return __builtin_amdgcn_s_memrealtime(); }
#define XB_TMO      128
#define XB_XCNT(j)  (256  + 64 * (j))
#define XB_XSUB(j)  (1280 + 64 * (j))
#define XB_XGEN(j)  (2304 + 64 * (j))
#define XB_TOP      3328
#define XB_TOPGEN   3392
#define XCD_BAR_WORDS 3456
#define XB_SPIN_CAP (1u << 18)

__device__ __forceinline__ unsigned xb_ld(unsigned* p)              { return __hip_atomic_load(p, __ATOMIC_RELAXED, __HIP_MEMORY_SCOPE_AGENT); }
__device__ __forceinline__ unsigned xb_add(unsigned* p, unsigned v) { return __hip_atomic_fetch_add(p, v, __ATOMIC_RELAXED, __HIP_MEMORY_SCOPE_AGENT); }
__device__ __forceinline__ unsigned xb_xcc_id() { return (unsigned)__builtin_amdgcn_s_getreg((3 << 11) | 20) & 0xFu; }
#define XB_SPIN(cond, bar) do { unsigned _sp = 0; while (cond) { __builtin_amdgcn_s_sleep(1); \
    if ((++_sp & 255u) == 0u) { if (xb_ld(&(bar)[XB_TMO])) break; if (_sp > XB_SPIN_CAP) { atomicAdd(&(bar)[XB_TMO], 1u); break; } } } } while (0)

struct XcdBarrier {
    unsigned* bar; unsigned x;
    volatile LAS unsigned* st;
};

__device__ __forceinline__ XcdBarrier xcd_barrier_post(unsigned* bar, volatile LAS unsigned* st, bool leader) {
    XcdBarrier b; b.bar = bar; b.x = xb_xcc_id(); b.st = st;
    if (leader) (void)xb_add(&bar[XB_XCNT(b.x)], 1u);
    return b;
}
__device__ __forceinline__ void xcd_barrier_complete(unsigned* bar, unsigned x, unsigned& nloc, unsigned& nx) {
    const unsigned G = gridDim.x * gridDim.y * gridDim.z;
    unsigned sum, cnt, mine, sp = 0u;
    for (;;) {
        sum = 0u; cnt = 0u; mine = 0u;
#pragma unroll
        for (unsigned j = 0; j < 16; ++j) { const unsigned c = xb_ld(&bar[XB_XCNT(j)]); sum += c; cnt += (c > 0u) ? 1u : 0u; mine = (j == x) ? c : mine; }
        if (sum == G) break;
        __builtin_amdgcn_s_sleep(1);
        if ((++sp & 255u) == 0u) { if (xb_ld(&bar[XB_TMO])) break; if (sp > XB_SPIN_CAP) { atomicAdd(&bar[XB_TMO], 1u); break; } }
    }
    nloc = mine > 0u ? mine : 1u; nx = cnt > 0u ? cnt : 1u;
}

__device__ __forceinline__ void xcd_barrier(const XcdBarrier& b, bool leader  ) {
    asm volatile("s_waitcnt vmcnt(0)" ::: "memory");
    __syncthreads();
    if (leader) {
        unsigned* bar = b.bar;
        __builtin_amdgcn_s_waitcnt(0);
        unsigned nloc = b.st[0], nx = b.st[1];
        if (nloc == 0u) { xcd_barrier_complete(bar, b.x, nloc, nx); b.st[0] = nloc; b.st[1] = nx; }
        const unsigned old = xb_add(&bar[XB_XSUB(b.x)], 1u);
        const unsigned gen = old / nloc;
        if (old + 1u == (gen + 1u) * nloc) {
            __builtin_amdgcn_fence(__ATOMIC_RELEASE, "agent");
            asm volatile("s_waitcnt vmcnt(0)" ::: "memory");
            const unsigned og = xb_add(&bar[XB_TOP], 1u);
            const unsigned tg = og / nx;
            if (og + 1u == (tg + 1u) * nx) xb_add(&bar[XB_TOPGEN], 1u);
            else XB_SPIN(xb_ld(&bar[XB_TOPGEN]) == tg, bar);
            __builtin_amdgcn_fence(__ATOMIC_ACQUIRE, "agent");
            xb_add(&bar[XB_XGEN(b.x)], 1u);
            asm volatile("s_waitcnt vmcnt(0)" ::: "memory");
        } else {
            XB_SPIN(xb_ld(&bar[XB_XGEN(b.x)]) == gen, bar);
            __builtin_amdgcn_fence(__ATOMIC_ACQUIRE, "agent");
            asm volatile("s_waitcnt vmcnt(0)" ::: "memory");
        }
    }
    __syncthreads();
}

__device__ __forceinline__ void tr_item(const float* W, int ldw, int n0, int cnt, bf16* WT, int ldt, int row_off, const float* ksc, LAS float* scr, int item, int nblk, int lane) {
    const int kb = item / nblk, nb = item % nblk, k0 = 64 * kb, nn0 = 32 * nb;
#pragma unroll 8
    for (int i = 0; i < 32; ++i) { const int kk = 2 * i + (lane >> 5), n = nn0 + (lane & 31); float v = (n < cnt) ? W[(size_t)(k0 + kk) * ldw + n0 + n] : 0.f; if (ksc) v *= ksc[k0 + kk]; scr[kk * 33 + (lane & 31)] = v; }
    asm volatile("s_waitcnt lgkmcnt(0)" ::: "memory");
    const int c = lane & 7;
#pragma unroll
    for (int j = 0; j < 4; ++j) { const int n = (lane >> 3) + 8 * j; const LAS float* s = scr + (8 * c) * 33 + n;
        v4u o; o.x = pk2(s[0 * 33], s[1 * 33]); o.y = pk2(s[2 * 33], s[3 * 33]); o.z = pk2(s[4 * 33], s[5 * 33]); o.w = pk2(s[6 * 33], s[7 * 33]);
        *(v4u*)(WT + (size_t)(row_off + nn0 + n) * ldt + k0 + 8 * c) = o; }
    asm volatile("s_waitcnt lgkmcnt(0)" ::: "memory");
}
struct Args { const float* in[22]; float* out; unsigned char* ws; int ph_lo, ph_hi; };
enum { I_X = 0, I_P, I_NORMG, I_WIN, I_MU, I_W0, I_WLORA, I_A0, I_ALORA, I_KK, I_KA, I_RK, I_LNG, I_LNB, I_BF, I_WUPR, I_WUPF, I_WOUT, I_PLEPROJ, I_PLEGATE, I_PLENORMG, I_FINALG };
constexpr int N_PHASES = 10;

__global__ void __launch_bounds__(NTHREADS, 2) mk_fwd(Args args) {
    extern __shared__ __attribute__((aligned(16))) unsigned char lds[];
    LAS unsigned char* const L = (LAS unsigned char*)lds;
    const int wave = __builtin_amdgcn_readfirstlane(threadIdx.x >> 6);
    const int G = gridDim.x, bx = blockIdx.x, vcu = (G % 8 == 0) ? (bx % 8) * (G / 8) + bx / 8 : bx;
    const int gw = vcu * NWAVES + wave, NGW = G * NWAVES;
#define LANE_HERE const int lane = lane_id()
    unsigned char* const ws = args.ws; unsigned char* const ob = (unsigned char*)args.out;
    const int lo = args.ph_lo, hi = args.ph_hi;
#ifndef PH_MASK
#define PH_MASK 0x3ff
#endif
#define IN(k) (((PH_MASK >> (k)) & 1) && lo <= (k) && (k) < hi)
#define SEAM(k) do { if (IN(k) && IN((k) + 1)) { if ((k) == 0) cg::this_grid().sync(); else xcd_barrier(xbar, wave == 0 && lane_id() == 0); } } while (0)
    { volatile LAS unsigned* misc = (volatile LAS unsigned*)(L + MISC_OFF); if (threadIdx.x < 16) misc[threadIdx.x] = 0u; __syncthreads(); }
    const XcdBarrier xbar = xcd_barrier_post((unsigned*)(ws + WS_CTL) + CW_BAR, (volatile LAS unsigned*)(L + MISC_OFF) + 8, threadIdx.x == 0);
    bf16* const WinT = (bf16*)(ws + WS_WIN); bf16* const WupRT = (bf16*)(ws + WS_WUPR); bf16* const WupFT = (bf16*)(ws + WS_WUPF); bf16* const WoT = (bf16*)(ws + WS_WO);
    bf16* const WgT = (bf16*)(ws + WS_WGATE); bf16* const WpT = (bf16*)(ws + WS_WPLE); bf16* const WlT = (bf16*)(ws + WS_WLORA);
    bf16* const ZRW = (bf16*)(ws + WS_ZRW); bf16* const ZFX = (bf16*)(ws + WS_ZFX); bf16* const ZG = (bf16*)(ws + WS_ZG); float* const ZS = (float*)(ws + WS_ZS);
    bf16* const LA = (bf16*)(ws + WS_LA); bf16* const PB = (bf16*)(ws + WS_PB); float* const CF = (float*)(ws + WS_CF); float* const SS1 = (float*)(ws + WS_SS1); float* const SS2 = (float*)(ws + WS_SS2);
    bf16* const T1 = (bf16*)(ws + WS_T1); bf16* const MG = (bf16*)(ws + WS_MG); float* const X1 = (float*)(ws + WS_X1); bf16* const X1B = (bf16*)(ws + WS_X1B); bf16* const PLEB = (bf16*)(ws + WS_PLE);
    bf16* const HB = (bf16*)(ob + OUT_H); float* const DEC = (float*)(ob + OUT_DEC); bf16* const AG = (bf16*)(ob + OUT_AG); bf16* const YR = (bf16*)(ob + OUT_YR);

    if (IN(0)) {
        LANE_HERE;
        LAS float* scr = (LAS float*)(L + wave * 16384);
        const float* w_in = args.in[I_WIN];
        struct Job { const float* W; int K, ldw, n0, cnt; bf16* WT; int ldt, row_off; const float* ksc; };
#define TRJOB(W_, K_, ldw_, n0_, cnt_, WT_, ldt_, ro_, ksc_) do { const int nblk_ = ((cnt_) + 31) / 32, items_ = ((K_) / 64) * nblk_; \
        for (int it = gw; it < items_; it += NGW) tr_item(W_, ldw_, n0_, cnt_, WT_, ldt_, ro_, ksc_, scr, it, nblk_, lane); } while (0)
        TRJOB(w_in, D, N_IN, 0, 4096, WinT, D, 0, nullptr);
        TRJOB(w_in, D, N_IN, 4224, 4096, WinT, D, 4096, nullptr);
        TRJOB(w_in, D, N_IN, 8336, 4096, WinT, D, 8192, nullptr);
        TRJOB(w_in, D, N_IN, 4096, 128, WinT, D, 12288, nullptr);
        TRJOB(w_in, D, N_IN, 8320, 16, WinT, D, 12416, nullptr);
        for (int i = gw * 64 + lane; i < (NZ - 12448) * D / 8; i += NGW * 64) *(v4u*)(WinT + (size_t)12448 * D + (size_t)i * 8) = (v4u){0u, 0u, 0u, 0u};
        TRJOB(args.in[I_WUPR], C, D, 0, D, WupRT, C, 0, nullptr);
        TRJOB(args.in[I_WUPF], C, D, 0, D, WupFT, C, 0, nullptr);
        TRJOB(args.in[I_WOUT], D, D, 0, D, WoT, D, 0, nullptr);
        TRJOB(args.in[I_PLEGATE], D, D, 0, D, WgT, D, 0, args.in[I_PLENORMG]);
        TRJOB(args.in[I_PLEPROJ], PLE, D, 0, D, WpT, PLE, 0, nullptr);
#undef TRJOB
        for (int i = gw * 64 + lane; i < 2048 * 32; i += NGW * 64) { const int n = i >> 5, kc = i & 31, k0 = 8 * kc; float v[8];
#pragma unroll
            for (int e = 0; e < 8; ++e) v[e] = 0.f;
            if (n < 1024 && k0 < 64) {
#pragma unroll
                for (int e = 0; e < 8; ++e) v[e] = args.in[I_WLORA][(size_t)(k0 + e) * C + n]; }
            else if (n >= 1024 && k0 >= 64 && k0 < 128) {
#pragma unroll
                for (int e = 0; e < 8; ++e) v[e] = args.in[I_ALORA][(size_t)(k0 - 64 + e) * C + (n - 1024)]; }
            *(v4u*)(WlT + (size_t)n * 256 + k0) = (v4u){pk2(v[0], v[1]), pk2(v[2], v[3]), pk2(v[4], v[5]), pk2(v[6], v[7])}; }
        { const float* x = args.in[I_X]; const float* g = args.in[I_NORMG]; f32x4 gv[8];
#pragma unroll
          for (int j = 0; j < 8; ++j) gv[j] = ((const f32x4*)g)[lane + 64 * j];
          for (int m = gw; m < M; m += NGW) { const f32x4* xr = (const f32x4*)(x + (size_t)m * D) + lane; f32x4 v[8]; float s = 0.f;
#pragma unroll
            for (int j = 0; j < 8; ++j) { v[j] = xr[64 * j]; s += (v[j].x * v[j].x + v[j].y * v[j].y) + (v[j].z * v[j].z + v[j].w * v[j].w); }
            const float rstd = 1.f / sqrtf(wave_sum(s) * (1.f / D) + NORM_EPS);
            v2u* o8 = (v2u*)(HB + (size_t)m * D) + lane;
#pragma unroll
            for (int j = 0; j < 8; ++j) { const f32x4 y = v[j] * rstd * gv[j]; o8[64 * j] = (v2u){pk2(y.x, y.y), pk2(y.z, y.w)}; } } }
        { const float* p = args.in[I_P];
          for (int i = gw * 64 + lane; i < M * PLE / 8; i += NGW * 64) { const f32x4 a = ((const f32x4*)p)[2 * i], b = ((const f32x4*)p)[2 * i + 1];
            *(v4u*)(PB + (size_t)i * 8) = (v4u){pk2(a.x, a.y), pk2(a.z, a.w), pk2(b.x, b.y), pk2(b.z, b.w)}; } }
    }
    SEAM(0);
    if (IN(1)) {
        pg8::Gemm g{HB, WinT, M, NZ, D, D, D}; pg8::StaticOrder S; S.init(M, NZ, G, bx);
        pg8::EpiZ E{ZRW, (size_t)(WS_ZFX - WS_ZRW) / 2, ZS, attn_body::C2};
        pg8::gemm_phase<pg8::EpiZ, pg8::StaticOrder, true, true>(L, g, S, E, wave);
    }
    SEAM(1);
    if (IN(2)) {
        LANE_HERE;
        const float* mu = args.in[I_MU];
        if (gw < BATCH * H) {
            const int b = gw / H, h = gw % H; const float bf = args.in[I_BF][h]; const float* src = ZS + ((size_t)b * T + 64 * lane) * 256 + 128 + h; float s = 0.f;
            for (int i = 0; i < 64; ++i) { const float xx = src[(size_t)i * 256] + bf; s += fminf(xx, 0.f) - log1pf(expf(-fabsf(xx))); }
            float incl = s;
#pragma unroll
            for (int o = 1; o < 64; o <<= 1) { const float n = __shfl_up(incl, o); if (lane >= o) incl += n; }
            float run = incl - s; float* dst = CF + (size_t)gw * T + 64 * lane;
            for (int i = 0; i < 64; ++i) { const float xx = src[(size_t)i * 256] + bf; run += fminf(xx, 0.f) - log1pf(expf(-fabsf(xx))); dst[i] = run * 1.4426950408889634f; }
        }
        for (int i = gw * 64 + lane; i < M * 32; i += NGW * 64) { const int m = i >> 5, c8 = i & 31; v4u o = (v4u){0u, 0u, 0u, 0u};
            if (c8 < 16) { const float* zc = ZS + (size_t)m * 256 + 8 * c8; const f32x4 a0 = *(const f32x4*)zc, a1 = *(const f32x4*)(zc + 4); f32x4 p0 = {0.f, 0.f, 0.f, 0.f}, p1 = p0;
                if ((m & (T - 1)) != 0) { p0 = *(const f32x4*)(zc - 256); p1 = *(const f32x4*)(zc - 252); }
                const f32x4 m0 = *(const f32x4*)(mu + 4096 + 8 * c8), m1 = *(const f32x4*)(mu + 4100 + 8 * c8);
                f32x4 s0 = a0 + (p0 - a0) * m0, s1 = a1 + (p1 - a1) * m1;
                if (c8 < 8) {
#pragma unroll
                    for (int e = 0; e < 4; ++e) { s0[e] = tanhf(s0[e]); s1[e] = tanhf(s1[e]); } }
                o = (v4u){pk2(s0.x, s0.y), pk2(s0.z, s0.w), pk2(s1.x, s1.y), pk2(s1.z, s1.w)}; }
            *(v4u*)(LA + (size_t)m * 256 + 8 * c8) = o; }
    }
    SEAM(2);
    if (IN(3)) {
        pg8::Gemm g{LA, WlT, M, 2048, 256, 256, 256}; pg8::StaticOrder S; S.init(M, 2048, G, bx);
        pg8::EpiLora E{DEC, AG, args.in[I_W0], args.in[I_A0]};
        pg8::gemm_phase<pg8::EpiLora, pg8::StaticOrder, true, true>(L, g, S, E, wave);
    }
    SEAM(3);
    if (IN(4)) {
#ifndef NO_SCAN
        if (bx < BATCH * H) {
            scan::Params SP{ZRW, DEC, AG, YR, args.in[I_MU], args.in[I_KK], args.in[I_KA], args.in[I_RK], args.in[I_LNG], args.in[I_LNB]};
            scan::scan_head(L, SP, bx, wave);
        }
#endif
#ifndef NO_ATTN
        unsigned* qctr = (unsigned*)(ws + WS_CTL); volatile LAS unsigned* slot = (volatile LAS unsigned*)(L + MISC_OFF);
        for (;;) {
            if (wave == 0 && lane_id() == 0) slot[0] = atomicAdd(qctr, 1u);
            __syncthreads();
            const unsigned idx = slot[0];
            __syncthreads();
            if (idx >= 1024u) break;
            const int qb = 15 - (int)(idx >> 6), bh = (int)(idx & 63u);
            attn_body::attn_unit<8>(bh >> 4, bh & 15, qb, (const attn_body::bf16*)ZFX, (const attn_body::bf16*)(ZFX + 1024), (const attn_body::bf16*)(ZFX + 2048), (const attn_body::bf16*)(ZFX + 3072), CF, (attn_body::bf16*)ZFX, (char*)lds, wave);
        }
#endif
    }
    SEAM(4);
    if (IN(5)) {
        { pg8::Gemm g{YR, WupRT, M, D, C, C, C}; pg8::StaticOrder S; S.init(M, D, G, bx); pg8::EpiT1 E{T1, ZG};
          pg8::gemm_phase<pg8::EpiT1, pg8::StaticOrder, true, true>(L, g, S, E, wave); }
    }
    SEAM(5);
    if (IN(6)) {
        pg8::Gemm g{ZFX, WupFT, M, D, C, 4096, C}; pg8::StaticOrder S; S.init(M, D, G, bx); pg8::EpiMerge E{T1, ZG, MG};
        pg8::gemm_phase<pg8::EpiMerge, pg8::StaticOrder, true, true>(L, g, S, E, wave);
    }
    SEAM(6);
    if (IN(7)) {
        { pg8::Gemm g{MG, WoT, M, D, D, D, D}; pg8::StaticOrder S; S.init(M, D, G, bx); pg8::EpiX1 E{args.in[I_X], X1, X1B, SS1};
          pg8::gemm_phase<pg8::EpiX1, pg8::StaticOrder, true, true>(L, g, S, E, wave); }
        { pg8::Gemm g{PB, WpT, M, D, PLE, PLE, PLE}; pg8::StaticOrder S; S.init(M, D, G, bx); pg8::EpiPlain E{PLEB, D};
          pg8::gemm_phase<pg8::EpiPlain, pg8::StaticOrder, true, true>(L, g, S, E, wave); }
    }
    SEAM(7);
    if (IN(8)) {
        pg8::Gemm g{X1B, WgT, M, D, D, D, D}; pg8::StaticOrder S; S.init(M, D, G, bx); pg8::EpiX2 E{X1, PLEB, SS1, args.out, SS2, NORM_EPS};
        pg8::gemm_phase<pg8::EpiX2, pg8::StaticOrder, true, true>(L, g, S, E, wave);
    }
    SEAM(8);
    if (IN(9)) {
        LANE_HERE;
        const float* g = args.in[I_FINALG]; f32x4 gv[8];
#pragma unroll
        for (int j = 0; j < 8; ++j) gv[j] = ((const f32x4*)g)[lane + 64 * j];
        for (int m = gw; m < M; m += NGW) { const float sp = (lane < 32) ? SS2[(size_t)m * 32 + lane] : 0.f; const float rstd = 1.f / sqrtf(wave_sum(sp) * (1.f / D) + NORM_EPS);
            f32x4* xr = (f32x4*)(args.out + (size_t)m * D) + lane;
#pragma unroll
            for (int j = 0; j < 8; ++j) xr[64 * j] = xr[64 * j] * rstd * gv[j]; }
    }
#undef IN
#undef SEAM
}

extern "C" void kernel_launch(void* const* d_in, const int* in_sizes, int n_in, void* d_out, int out_size, void* d_ws, size_t ws_size, hipStream_t stream) {
    static int grid = 0;
    if (grid == 0) {
        if (n_in != 22 || out_size != M * D || ws_size < WS_END) { fprintf(stderr, "kernel_launch: unexpected shapes (n_in %d, out %d, ws %zu)\n", n_in, out_size, ws_size); grid = -1; return; }
        int dev = 0, cus = 0, per_cu = 0;
        hipGetDevice(&dev); hipDeviceGetAttribute(&cus, hipDeviceAttributeMultiprocessorCount, dev);
        if (hipFuncSetAttribute((const void*)mk_fwd, hipFuncAttributeMaxDynamicSharedMemorySize, LDS_BYTES) != hipSuccess) { fprintf(stderr, "kernel_launch: hipFuncSetAttribute failed\n"); grid = -1; return; }
        if (hipOccupancyMaxActiveBlocksPerMultiprocessor(&per_cu, (const void*)mk_fwd, NTHREADS, LDS_BYTES) != hipSuccess || per_cu < 1) { fprintf(stderr, "kernel_launch: occupancy query says %d\n", per_cu); per_cu = 1; }
        (void)hipGetLastError();
        grid = cus;
        if (grid % 8 != 0 || grid > 256) grid = (grid > 256) ? 256 : (grid / 8) * 8;
    }
    if (grid <= 0) return;
    hipMemsetAsync((char*)d_ws + WS_CTL, 0, CTL_ZERO_BYTES, stream);
    Args a{};
    for (int i = 0; i < 22; ++i) a.in[i] = (const float*)d_in[i];
    a.out = (float*)d_out; a.ws = (unsigned char*)d_ws;
#if MK_PER_PHASE_LAUNCHES
    for (int p = 0; p < N_PHASES; ++p) { a.ph_lo = p; a.ph_hi = p + 1; hipLaunchKernelGGL(mk_fwd, dim3(grid), dim3(NTHREADS), LDS_BYTES, stream, a); }
#else
    a.ph_lo = 0; a.ph_hi = N_PHASES;
    void* kargs[] = {&a};
    hipError_t e = hipLaunchCooperativeKernel((const void*)mk_fwd, dim3(grid), dim3(NTHREADS), kargs, LDS_BYTES, stream);
    if (e != hipSuccess) fprintf(stderr, "kernel_launch: cooperative launch failed: %s (grid %d)\n", hipGetErrorString(e), grid);
#endif
}
```

```cpp
#include <hip/hip_runtime.h>
#include <cstdio>
#include <cstdint>
__device__ __forceinline__ int lane_id() { int l; asm volatile("v_mbcnt_lo_u32_b32 %0, -1, 0\n\tv_mbcnt_hi_u32_b32 %0, -1, %0" : "=v"(l)); return l; }
namespace pg8 {
#define PG8_LAS __attribute__((address_space(3)))
typedef unsigned short bf16_t;
typedef short bf16x8 __attribute__((ext_vector_type(8)));
typedef float f32x4 __attribute__((ext_vector_type(4)));
typedef unsigned u32x4 __attribute__((ext_vector_type(4)));
constexpr int BM = 256, BK = 64, HALF = 128, HTB = HALF * BK * 2  , STAGE_BYTES = 8 * HTB, NXCD = 8, WGM = 3;

__host__ __device__ __forceinline__ int lds_byte(int r, int c) { const int st = (r >> 4) * 2 + (c >> 5), rr = r & 15, cc = c & 31, ob = rr * 64 + cc * 2; return st * 1024 + (ob ^ (((ob >> 9) & 1) << 5)); }
__host__ __device__ __forceinline__ void stage_rc(int b, int& R, int& C) { const int st = b / 1024, sb = b % 1024, swz = sb ^ (((sb >> 9) & 1) << 5); R = (st >> 1) * 16 + swz / 64; C = (st & 1) * 32 + (swz % 64) / 2; }
__host__ __device__ __forceinline__ int perm32(int rho) { const int n = rho >> 4, i = rho & 15; return 8 * (i >> 2) + 4 * n + (i & 3); }

struct Unit { int pm, pn; };
struct Gemm { const bf16_t* A; const bf16_t* Bt; int M, N, K, lda, ldb; };

struct StaticOrder {
    int nM, nN, nwg, G, c;
    __host__ __device__ void init(int M, int N, int G_, int c_) { nM = M / BM; nN = N / BM; nwg = nM * nN; G = G_; c = c_; }
    __host__ __device__ bool next(int i, Unit& u) const {
        const long L = (long)i * G + c; if (L >= nwg) return false;
        int wgid = (int)L; { const int q = nwg / NXCD, r = nwg % NXCD, xcd = wgid % NXCD, off = wgid / NXCD; wgid = (xcd < r ? xcd * (q + 1) : r * (q + 1) + (xcd - r) * q) + off; }
        const int nig = WGM * nN, gid = wgid / nig, fm = gid * WGM, gsz = (nM - fm) < WGM ? (nM - fm) : WGM;
        u.pm = fm + ((wgid % nig) % gsz); u.pn = (wgid % nig) / gsz; return true;
    }
    __device__ __forceinline__ void a_ready(const Unit&) const {}
    __device__ __forceinline__ void done(const Unit&) const {}
};

__device__ __forceinline__ unsigned cvt_pk_bf16(float lo, float hi) { unsigned r; asm volatile("v_cvt_pk_bf16_f32 %0, %1, %2" : "=v"(r) : "v"(lo), "v"(hi)); return r; }
__device__ __forceinline__ float sigm(float x) { return __builtin_amdgcn_rcpf(1.f + __builtin_amdgcn_exp2f(-1.4426950408889634f * x)); }
__device__ __forceinline__ float bf_lo(unsigned u) { return __uint_as_float(u << 16); }
__device__ __forceinline__ float bf_hi(unsigned u) { return __uint_as_float(u & 0xffff0000u); }
__device__ __forceinline__ u32x4 pack8(const f32x4& v0, const f32x4& v1) { u32x4 w; w.x = cvt_pk_bf16(v0[0], v0[1]); w.y = cvt_pk_bf16(v0[2], v0[3]); w.z = cvt_pk_bf16(v1[0], v1[1]); w.w = cvt_pk_bf16(v1[2], v1[3]); return w; }
__device__ __forceinline__ void unpack8(const u32x4& w, f32x4& v0, f32x4& v1) { v0 = (f32x4){bf_lo(w.x), bf_hi(w.x), bf_lo(w.y), bf_hi(w.y)}; v1 = (f32x4){bf_lo(w.z), bf_hi(w.z), bf_lo(w.w), bf_hi(w.w)}; }
__device__ __forceinline__ size_t nat_base(int tile, int wr, int wc, int fr, int fq) {
    (void)fr; (void)fq; return (size_t)tile * 65536 + (size_t)(((wr * 4 + wc) * 64 + lane_id()) * 8); }
#define NAT_STEP(ai, m, bj) (((((ai) * 4 + (m)) * 2 + (bj)) * 4096))
__device__ __forceinline__ size_t t1_off(int tile, int step, int wr, int wc) { const int ch = (tile * 16 + step) * 8 + wr * 4 + wc; return (size_t)(ch >> 2) * 4096 + (size_t)((ch & 3) * 512) + (size_t)(lane_id() * 8); }
typedef unsigned u32x2_t __attribute__((ext_vector_type(2)));
__device__ __forceinline__ size_t nat_base8(int tile, int wr, int wc) { return (size_t)tile * 65536 + (size_t)(((wr * 4 + wc) * 64 + lane_id()) * 8); }
#define NAT8_STEP(ai, m, bj) (((((ai) * 4 + (m)) * 2 + (bj)) * 4096))
__device__ __forceinline__ unsigned q8(float s) { return (unsigned)(s * 255.f + 0.5f); }
__device__ __forceinline__ u32x2_t pack8u(const f32x4& v0, const f32x4& v1) { u32x2_t w; w.x = q8(v0[0]) | (q8(v0[1]) << 8) | (q8(v0[2]) << 16) | (q8(v0[3]) << 24); w.y = q8(v1[0]) | (q8(v1[1]) << 8) | (q8(v1[2]) << 16) | (q8(v1[3]) << 24); return w; }
__device__ __forceinline__ void unpack8u(const u32x2_t& w, f32x4& g0, f32x4& g1) { const float k = 1.f / 255.f;
    g0 = (f32x4){(float)(w.x & 255u) * k, (float)((w.x >> 8) & 255u) * k, (float)((w.x >> 16) & 255u) * k, (float)(w.x >> 24) * k}; g1 = (f32x4){(float)(w.y & 255u) * k, (float)((w.y >> 8) & 255u) * k, (float)((w.y >> 16) & 255u) * k, (float)(w.y >> 24) * k}; }
#define PG8_EPI_LOOP _Pragma("unroll") for (int ai = 0; ai < 2; ++ai) _Pragma("unroll") for (int m = 0; m < 4; ++m)

struct EpiZ {
    static constexpr bool PERM = true, AFTER_DRAIN = false;
    bf16_t* Z0; size_t seg_stride; float* ZS; float qscale; unsigned* NRM; float* FL;
    __device__ __forceinline__ void operator()(const f32x4 (&acc)[2][2][4][2], const Unit& u, int wr, int wc, int fr, int fq) const {
        const int seg = u.pn >> 4, ct = u.pn & 15, row0 = u.pm * BM + wr * 64 + fr;
        if (seg == 3) {
            const int col0 = wc * 32 + 8 * fq;
            PG8_EPI_LOOP { float* rowp = ZS + (size_t)(row0 + ai * HALF + m * 16) * 256 + col0;
#pragma unroll
                for (int bj = 0; bj < 2; ++bj) { *(f32x4*)(rowp + bj * HALF) = acc[ai][bj][m][0]; *(f32x4*)(rowp + bj * HALF + 4) = acc[ai][bj][m][1]; }
                if (wc == 0 && fq < 2) { float* fp = FL + (size_t)(row0 + ai * HALF + m * 16) * 16 + 8 * fq; *(f32x4*)fp = acc[ai][1][m][0]; *(f32x4*)(fp + 4) = acc[ai][1][m][1]; } }
        } else {
            bf16_t* base = Z0 + (size_t)seg * seg_stride;
            const int col0 = ct * 256 + wc * 32 + 8 * fq;
            const float sc = (seg == 1 && ct < 4) ? qscale : 1.f;
            const bool sg = (seg == 2);
            const bool nrm = (seg == 1 && ct < 8); float mx0 = 0.f, mx1 = 0.f;
            unsigned char* const natp8 = (unsigned char*)base + nat_base8(u.pm * 16 + ct, wr, wc);
            PG8_EPI_LOOP { bf16_t* rowp = base + (size_t)(row0 + ai * HALF + m * 16) * 4096 + col0;
#pragma unroll
                for (int bj = 0; bj < 2; ++bj) { f32x4 v0 = acc[ai][bj][m][0] * sc, v1 = acc[ai][bj][m][1] * sc;
                    if (sg) {
#pragma unroll
                        for (int e = 0; e < 4; ++e) { v0[e] = sigm(v0[e]); v1[e] = sigm(v1[e]); } }
                    if (sg) *(u32x2_t*)(natp8 + NAT8_STEP(ai, m, bj)) = pack8u(v0, v1);
                    else *(u32x4*)(rowp + bj * HALF) = pack8(v0, v1);
                    if (nrm) { float s = (v0[0] * v0[0] + v0[1] * v0[1]) + (v0[2] * v0[2] + v0[3] * v0[3]) + (v1[0] * v1[0] + v1[1] * v1[1]) + (v1[2] * v1[2] + v1[3] * v1[3]);
                        s += __shfl_xor(s, 16); s += __shfl_xor(s, 32); if (bj == 0) mx0 = fmaxf(mx0, s); else mx1 = fmaxf(mx1, s); } } }
            if (nrm) {
#pragma unroll
                for (int o = 1; o < 16; o <<= 1) { mx0 = fmaxf(mx0, __shfl_xor(mx0, o)); mx1 = fmaxf(mx1, __shfl_xor(mx1, o)); }
                if (fr == 0 && fq == 0) { const int bb_ = u.pm >> 4, hd = (ct & 3) * 4 + (wc >> 1), kq_ = ct >> 2;
                    atomicMax(NRM + ((bb_ * 16 + hd) * 2 + kq_), __float_as_uint(mx0)); atomicMax(NRM + ((bb_ * 16 + hd + 2) * 2 + kq_), __float_as_uint(mx1)); } }
        }
    }
};
struct EpiZSAdd {
    static constexpr bool PERM = true, AFTER_DRAIN = false;
    float* ZS;
    __device__ __forceinline__ void operator()(const f32x4 (&acc)[2][2][4][2], const Unit& u, int wr, int wc, int fr, int fq) const {
        const int row0 = u.pm * BM + wr * 64 + fr, col0 = wc * 32 + 8 * fq;
        PG8_EPI_LOOP { float* rowp = ZS + (size_t)(row0 + ai * HALF + m * 16) * 256 + col0;
#pragma unroll
            for (int bj = 0; bj < 2; ++bj)
#pragma unroll
                for (int n = 0; n < 2; ++n)
#pragma unroll
                    for (int e = 0; e < 4; ++e) { const int c = col0 + bj * HALF + 4 * n + e; if (c < 160) __hip_atomic_fetch_add(rowp + bj * HALF + 4 * n + e, acc[ai][bj][m][n][e], __ATOMIC_RELAXED, __HIP_MEMORY_SCOPE_AGENT); } }
    }
};
struct EpiLora {
    static constexpr bool PERM = true, AFTER_DRAIN = false;
    bf16_t* DEC; bf16_t* AG; const float* w0; const float* a0;
    __device__ __forceinline__ void operator()(const f32x4 (&acc)[2][2][4][2], const Unit& u, int wr, int wc, int fr, int fq) const {
        const int row0 = u.pm * BM + wr * 64 + fr; const bool isw = u.pn < 4;
        const int col0 = (u.pn & 3) * 256 + wc * 32 + 8 * fq; const float* bias = isw ? w0 : a0;
        f32x4 bv[2][2];
#pragma unroll
        for (int bj = 0; bj < 2; ++bj) { bv[bj][0] = *(const f32x4*)(bias + col0 + bj * HALF); bv[bj][1] = *(const f32x4*)(bias + col0 + bj * HALF + 4); }
        PG8_EPI_LOOP { const size_t ro = (size_t)(row0 + ai * HALF + m * 16) * 1024 + col0;
#pragma unroll
            for (int bj = 0; bj < 2; ++bj) { f32x4 v0 = acc[ai][bj][m][0] + bv[bj][0], v1 = acc[ai][bj][m][1] + bv[bj][1];
#pragma unroll
                for (int e = 0; e < 4; ++e) { v0[e] = sigm(v0[e]); v1[e] = sigm(v1[e]); }
                if (isw) {
#pragma unroll
                    for (int e = 0; e < 4; ++e) { v0[e] = __builtin_amdgcn_exp2f(-0.8750612634f * v0[e]); v1[e] = __builtin_amdgcn_exp2f(-0.8750612634f * v1[e]); }
                    typedef _Float16 h8 __attribute__((ext_vector_type(8))); h8 hv;
#pragma unroll
                    for (int e = 0; e < 4; ++e) { hv[e] = (_Float16)(1.f - v0[e]); hv[4 + e] = (_Float16)(1.f - v1[e]); }
                    *(h8*)(DEC + ro + bj * HALF) = hv;
                } else *(u32x4*)(AG + ro + bj * HALF) = pack8(v0, v1); } }
    }
};
struct EpiPlain {
    static constexpr bool PERM = true, AFTER_DRAIN = false;
    bf16_t* O; int ldc;
    __device__ __forceinline__ void operator()(const f32x4 (&acc)[2][2][4][2], const Unit& u, int wr, int wc, int fr, int fq) const {
        const int row0 = u.pm * BM + wr * 64 + fr, col0 = u.pn * BM + wc * 32 + 8 * fq;
        PG8_EPI_LOOP { bf16_t* rowp = O + (size_t)(row0 + ai * HALF + m * 16) * ldc + col0;
#pragma unroll
            for (int bj = 0; bj < 2; ++bj) *(u32x4*)(rowp + bj * HALF) = pack8(acc[ai][bj][m][0], acc[ai][bj][m][1]); }
    }
};
struct EpiPlainN {
    static constexpr bool PERM = true, AFTER_DRAIN = false;
    bf16_t* O;
    __device__ __forceinline__ void operator()(const f32x4 (&acc)[2][2][4][2], const Unit& u, int wr, int wc, int fr, int fq) const {
        bf16_t* const op = O + nat_base(u.pm * 8 + u.pn, wr, wc, fr, fq);
        PG8_EPI_LOOP {
#pragma unroll
            for (int bj = 0; bj < 2; ++bj) *(u32x4*)(op + NAT_STEP(ai, m, bj)) = pack8(acc[ai][bj][m][0], acc[ai][bj][m][1]); }
    }
};
struct EpiT1 {
    static constexpr bool PERM = true, AFTER_DRAIN = false;
    bf16_t* T1; const bf16_t* ZG; int goff; int ldt;
    __device__ __forceinline__ void operator()(const f32x4 (&acc)[2][2][4][2], const Unit& u, int wr, int wc, int fr, int fq) const {
        const int row0 = u.pm * BM + wr * 64 + fr, col0 = u.pn * BM + wc * 32 + 8 * fq;
        u32x2_t gz[2][4][2];
        const unsigned char* const zgp = (const unsigned char*)ZG + nat_base8(u.pm * 16 + (goff >> 8) + u.pn, wr, wc);
#pragma unroll
        for (int ai = 0; ai < 2; ++ai)
#pragma unroll
            for (int m = 0; m < 4; ++m)
#pragma unroll
                for (int bj = 0; bj < 2; ++bj) gz[ai][m][bj] = __builtin_nontemporal_load((const u32x2_t*)(zgp + NAT8_STEP(ai, m, bj)));
        __builtin_amdgcn_sched_barrier(0);
#pragma unroll
        for (int ai = 0; ai < 2; ++ai)
#pragma unroll
            for (int m = 0; m < 4; ++m) { const size_t r = (size_t)(row0 + ai * HALF + m * 16);
#pragma unroll
                for (int bj = 0; bj < 2; ++bj) { f32x4 g0, g1; unpack8u(gz[ai][m][bj], g0, g1);
                    *(u32x4*)(T1 + t1_off(u.pm * 8 + u.pn, (ai * 4 + m) * 2 + bj, wr, wc)) = pack8(acc[ai][bj][m][0] * g0, acc[ai][bj][m][1] * g1); } }
        __builtin_amdgcn_sched_barrier(0);
    }
};
struct EpiMerge {
    static constexpr bool PERM = true, AFTER_DRAIN = false;
    const bf16_t* T1; const bf16_t* ZG; bf16_t* MG; int goff; int ldt;
    __device__ __forceinline__ void operator()(const f32x4 (&acc)[2][2][4][2], const Unit& u, int wr, int wc, int fr, int fq) const {
        const int row0 = u.pm * BM + wr * 64 + fr, col0 = u.pn * BM + wc * 32 + 8 * fq;
        u32x2_t gz[4][2][2]; u32x4 tz[4][2][2];
        const unsigned char* const zgp = (const unsigned char*)ZG + nat_base8(u.pm * 16 + (goff >> 8) + u.pn, wr, wc);
#define EM_LOAD(q) do { _Pragma("unroll") for (int mm = 0; mm < 2; ++mm) _Pragma("unroll") for (int bj = 0; bj < 2; ++bj) { const size_t r = (size_t)(row0 + ((q) >> 1) * HALF + (2 * ((q) & 1) + mm) * 16); \
            gz[q][mm][bj] = __builtin_nontemporal_load((const u32x2_t*)(zgp + NAT8_STEP((q) >> 1, 2 * ((q) & 1) + mm, bj))); tz[q][mm][bj] = __builtin_nontemporal_load((const u32x4*)(T1 + t1_off(u.pm * 8 + u.pn, ((((q) >> 1) * 4 + 2 * ((q) & 1) + mm) * 2 + bj), wr, wc))); } } while (0)
#define EM_DO(q) do { _Pragma("unroll") for (int mm = 0; mm < 2; ++mm) { const int m = 2 * ((q) & 1) + mm; const size_t r = (size_t)(row0 + ((q) >> 1) * HALF + m * 16); \
            _Pragma("unroll") for (int bj = 0; bj < 2; ++bj) { f32x4 g0, g1, t0, t1; unpack8u(gz[q][mm][bj], g0, g1); unpack8(tz[q][mm][bj], t0, t1); \
                *(u32x4*)(MG + r * 2048 + col0 + bj * HALF) = pack8(t0 + acc[(q) >> 1][bj][m][0] * g0, t1 + acc[(q) >> 1][bj][m][1] * g1); } } } while (0)
        EM_LOAD(0); EM_LOAD(1); __builtin_amdgcn_sched_barrier(0);
        EM_DO(0); __builtin_amdgcn_sched_barrier(0); EM_LOAD(2); __builtin_amdgcn_sched_barrier(0);
        EM_DO(1); __builtin_amdgcn_sched_barrier(0); EM_LOAD(3); __builtin_amdgcn_sched_barrier(0);
        EM_DO(2); __builtin_amdgcn_sched_barrier(0); EM_DO(3); __builtin_amdgcn_sched_barrier(0);
#undef EM_LOAD
#undef EM_DO
    }
};
struct EpiX1 {
    static constexpr bool PERM = true, AFTER_DRAIN = false;
    const bf16_t* XT; bf16_t* X1B; float* SS;
    __device__ __forceinline__ void operator()(const f32x4 (&acc)[2][2][4][2], const Unit& u, int wr, int wc, int fr, int fq) const {
        const int row0 = u.pm * BM + wr * 64 + fr, col0 = u.pn * BM + wc * 32 + 8 * fq;
        u32x4 xv[4][2][2]; const bf16_t* const xtp = XT + (size_t)(u.pm * 8 + u.pn) * 65536 + (size_t)((wr * 64 + fr) * 256 + wc * 32 + 8 * fq);
#define EX_LOAD(q) do { _Pragma("unroll") for (int mm = 0; mm < 2; ++mm) _Pragma("unroll") for (int bj = 0; bj < 2; ++bj) \
            xv[q][mm][bj] = __builtin_nontemporal_load((const u32x4*)(xtp + (((q) >> 1) * HALF + (2 * ((q) & 1) + mm) * 16) * 256 + bj * HALF)); } while (0)
#define EX_DO(q) do { _Pragma("unroll") for (int mm = 0; mm < 2; ++mm) { const int m = 2 * ((q) & 1) + mm; const size_t r = (size_t)(row0 + ((q) >> 1) * HALF + m * 16); float ss = 0.f; \
            _Pragma("unroll") for (int bj = 0; bj < 2; ++bj) { const size_t o = r * 2048 + col0 + bj * HALF; \
                f32x4 x0_, x1_; unpack8(xv[q][mm][bj], x0_, x1_); const f32x4 v0 = acc[(q) >> 1][bj][m][0] + x0_, v1 = acc[(q) >> 1][bj][m][1] + x1_; \
                *(u32x4*)(X1B + o) = pack8(v0, v1); \
                ss += (v0[0] * v0[0] + v0[1] * v0[1]) + (v0[2] * v0[2] + v0[3] * v0[3]) + (v1[0] * v1[0] + v1[1] * v1[1]) + (v1[2] * v1[2] + v1[3] * v1[3]); } \
            ss += __shfl_xor(ss, 16); ss += __shfl_xor(ss, 32); \
            if (fq == 0) SS[r * 32 + u.pn * 4 + wc] = ss; } } while (0)
        EX_LOAD(0); EX_LOAD(1); __builtin_amdgcn_sched_barrier(0);
        EX_DO(0); __builtin_amdgcn_sched_barrier(0); EX_LOAD(2); __builtin_amdgcn_sched_barrier(0);
        EX_DO(1); __builtin_amdgcn_sched_barrier(0); EX_LOAD(3); __builtin_amdgcn_sched_barrier(0);
        EX_DO(2); __builtin_amdgcn_sched_barrier(0); EX_DO(3); __builtin_amdgcn_sched_barrier(0);
#undef EX_LOAD
#undef EX_DO
    }
};
struct EpiX2 {
    static constexpr bool PERM = true, AFTER_DRAIN = false;
    const bf16_t* X1B; const bf16_t* PLE; const float* SS1; bf16_t* X2B; float eps;
    __device__ __forceinline__ void operator()(const f32x4 (&acc)[2][2][4][2], const Unit& u, int wr, int wc, int fr, int fq) const {
        const int row0 = u.pm * BM + wr * 64 + fr, col0 = u.pn * BM + wc * 32 + 8 * fq;
        const bf16_t* const plp = PLE + nat_base(u.pm * 8 + u.pn, wr, wc, fr, fq);
#pragma unroll
        for (int ai = 0; ai < 2; ++ai)
#pragma unroll
            for (int mh = 0; mh < 2; ++mh) {
                u32x4 xh[2][2]; f32x4 sp[2][2]; u32x4 pz[2][2];
#pragma unroll
                for (int mm = 0; mm < 2; ++mm) { const size_t r = (size_t)(row0 + ai * HALF + (2 * mh + mm) * 16);
                    sp[mm][0] = *(const f32x4*)(SS1 + r * 32 + fq * 8); sp[mm][1] = *(const f32x4*)(SS1 + r * 32 + fq * 8 + 4);
#pragma unroll
                    for (int bj = 0; bj < 2; ++bj) { const size_t o = r * 2048 + col0 + bj * HALF; xh[mm][bj] = *(const u32x4*)(X1B + o); pz[mm][bj] = __builtin_nontemporal_load((const u32x4*)(plp + NAT_STEP(ai, 2 * mh + mm, bj))); } }
                __builtin_amdgcn_sched_barrier(0);
#pragma unroll
                for (int mm = 0; mm < 2; ++mm) { const int m = 2 * mh + mm; const size_t r = (size_t)(row0 + ai * HALF + m * 16);
                    const f32x4 p0 = sp[mm][0], p1 = sp[mm][1];
                    float s1 = (p0[0] + p0[1]) + (p0[2] + p0[3]) + (p1[0] + p1[1]) + (p1[2] + p1[3]); s1 += __shfl_xor(s1, 16); s1 += __shfl_xor(s1, 32);
                    const float nrs = -1.4426950408889634f * __builtin_amdgcn_rsqf(s1 * (1.f / 2048.f) + eps);
#pragma unroll
                    for (int bj = 0; bj < 2; ++bj) { const size_t o = r * 2048 + col0 + bj * HALF; f32x4 e0, e1; unpack8(pz[mm][bj], e0, e1);
                        f32x4 v0, v1; unpack8(xh[mm][bj], v0, v1);
#pragma unroll
                        for (int e_ = 0; e_ < 4; ++e_) { v0[e_] += e0[e_] * __builtin_amdgcn_rcpf(1.f + __builtin_amdgcn_exp2f(acc[ai][bj][m][0][e_] * nrs)); v1[e_] += e1[e_] * __builtin_amdgcn_rcpf(1.f + __builtin_amdgcn_exp2f(acc[ai][bj][m][1][e_] * nrs)); }
                        *(u32x4*)(X2B + o) = pack8(v0, v1); } }
                __builtin_amdgcn_sched_barrier(0);
            }
    }
};
template <class Epi, class Sched, bool ALIGN_EPI = false, bool SP2 = false>
__device__ __forceinline__ void gemm_phase(PG8_LAS unsigned char* lds, const Gemm g, const Sched& S, const Epi& E, const int wid  ) {
    const int lane = lane_id(), tid = wid * 64 + lane, wr = wid >> 2, wc = wid & 3, fr = lane & 15, fq = lane >> 4;
    const int K = g.K, nt = K / BK;
    unsigned voffA[2], voffB[2];
#pragma unroll
    for (int i = 0; i < 2; ++i) { int R, C; stage_rc(tid * 16 + i * 8192, R, C); const int Rb = Epi::PERM ? ((R & ~31) + perm32(R & 31)) : R;
        voffA[i] = (unsigned)(R * g.lda + C) * 2u; voffB[i] = (unsigned)(Rb * g.ldb + C) * 2u; }
    const size_t kstep = (size_t)(BK * 2);
    const size_t hstepA = (size_t)HALF * g.lda * 2, hstepB = (size_t)HALF * g.ldb * 2;
    const size_t tstepA = 2 * hstepA, tstepB = 2 * hstepB;
    const unsigned ldsw = (unsigned)wid * 1024u;
    const int aoff = lds_byte(wr * 64 + fr, fq * 8), boff = lds_byte(wc * 32 + fr, fq * 8);
#define PG8_SA(b, h) (((b) * 2 + (h)) * HTB)
#define PG8_SB(b, h) ((4 + (b) * 2 + (h)) * HTB)
#define PG8_STAGE(bufoff, gbase, voff) do { _Pragma("unroll") for (int _i = 0; _i < 2; ++_i) \
        __builtin_amdgcn_global_load_lds((const unsigned*)((const char*)(gbase) + (voff)[_i]), (PG8_LAS unsigned*)(lds + (bufoff) + ldsw + _i * 8192), 16, 0, 0); } while (0)
#define PG8_LDA(dst, b, h) do { _Pragma("unroll") for (int m = 0; m < 4; ++m) _Pragma("unroll") for (int k = 0; k < 2; ++k) dst[m][k] = *(const PG8_LAS bf16x8*)(lds + PG8_SA(b, h) + aoff + m * 2048 + k * 1024); } while (0)
#define PG8_LDB(dst, b, h) do { _Pragma("unroll") for (int n = 0; n < 2; ++n) _Pragma("unroll") for (int k = 0; k < 2; ++k) dst[n][k] = *(const PG8_LAS bf16x8*)(lds + PG8_SB(b, h) + boff + n * 2048 + k * 1024); } while (0)
#define PG8_MMA(ai, bj, At, Bt) do { __builtin_amdgcn_s_setprio(1); _Pragma("unroll") for (int m = 0; m < 4; ++m) _Pragma("unroll") for (int n = 0; n < 2; ++n) _Pragma("unroll") for (int k = 0; k < 2; ++k) \
        acc[ai][bj][m][n] = __builtin_amdgcn_mfma_f32_16x16x32_bf16(Bt[n][k], At[m][k], acc[ai][bj][m][n], 0, 0, 0); __builtin_amdgcn_s_setprio(0); } while (0)
#define PG8_WAIT_V(n) asm volatile("s_waitcnt vmcnt(" #n ")" ::: "memory")
#define PG8_WAIT_L(n) asm volatile("s_waitcnt lgkmcnt(" #n ")" ::: "memory")
#define PG8_BAR __builtin_amdgcn_s_barrier()
#define PG8_SCHED __builtin_amdgcn_sched_barrier(0)
    Unit cur, nxt; int ui = 0;
    if (!S.next(0, cur)) return;
    f32x4 acc[2][2][4][2];
#pragma unroll
    for (int a = 0; a < 2; ++a)
#pragma unroll
        for (int b = 0; b < 2; ++b)
#pragma unroll
            for (int m = 0; m < 4; ++m)
#pragma unroll
                for (int n = 0; n < 2; ++n) acc[a][b][m][n] = (f32x4){0.f, 0.f, 0.f, 0.f};
    bf16x8 At[4][2], B0[2][2], B1[2][2];
    const char* cA = (const char*)g.A + (size_t)cur.pm * tstepA; const char* cB = (const char*)g.Bt + (size_t)cur.pn * tstepB;
    S.a_ready(cur);
    if constexpr (SP2) {
        PG8_STAGE(PG8_SB(0, 0), cB, voffB); PG8_STAGE(PG8_SB(0, 1), cB + hstepB, voffB); PG8_STAGE(PG8_SA(0, 0), cA, voffA); PG8_STAGE(PG8_SA(0, 1), cA + hstepA, voffA);
        if (wr == 1) PG8_BAR;
        PG8_WAIT_V(2); PG8_BAR;
        PG8_STAGE(PG8_SB(1, 0), cB + kstep, voffB); PG8_STAGE(PG8_SA(1, 0), cA + kstep, voffA); PG8_STAGE(PG8_SB(1, 1), cB + hstepB + kstep, voffB);
        PG8_WAIT_V(6); PG8_BAR;
    } else {
        PG8_STAGE(PG8_SB(0, 0), cB, voffB); PG8_STAGE(PG8_SA(0, 0), cA, voffA); PG8_STAGE(PG8_SB(0, 1), cB + hstepB, voffB); PG8_STAGE(PG8_SA(0, 1), cA + hstepA, voffA);
        if (wr == 1) PG8_BAR;
        PG8_WAIT_V(4); PG8_BAR;
        PG8_STAGE(PG8_SB(1, 0), cB + kstep, voffB); PG8_STAGE(PG8_SA(1, 0), cA + kstep, voffA); PG8_STAGE(PG8_SB(1, 1), cB + hstepB + kstep, voffB);
        PG8_WAIT_V(6); PG8_BAR;
    }
    for (;;) {
        const bool has_next = S.next(ui + 1, nxt);
        const char* nA = has_next ? (const char*)g.A + (size_t)nxt.pm * tstepA : cA; const char* nB = has_next ? (const char*)g.Bt + (size_t)nxt.pn * tstepB : cB;
        for (int t = 0; t < nt; t += 2) {
            const bool last = (t == nt - 2);
            const char* a1 = cA + (size_t)(t + 1) * kstep;
            const char* a2 = last ? nA : cA + (size_t)(t + 2) * kstep; const char* b2 = last ? nB : cB + (size_t)(t + 2) * kstep;
            const char* a3 = a2 + kstep; const char* b3 = b2 + kstep;
            if (last && has_next) S.a_ready(nxt);
            if constexpr (SP2) {
            PG8_LDB(B0, 0, 0); PG8_LDB(B1, 0, 1); PG8_SCHED; PG8_LDA(At, 0, 0); PG8_STAGE(PG8_SA(1, 1), a1 + hstepA, voffA);
            PG8_WAIT_V(8); PG8_WAIT_L(0); PG8_BAR; PG8_MMA(0, 0, At, B0); PG8_MMA(0, 1, At, B1); PG8_BAR; PG8_SCHED;
            PG8_LDA(At, 0, 1); PG8_STAGE(PG8_SB(0, 0), b2, voffB); PG8_STAGE(PG8_SB(0, 1), b2 + hstepB, voffB); PG8_STAGE(PG8_SA(0, 0), a2, voffA);
            PG8_WAIT_V(8); PG8_WAIT_L(0); PG8_BAR; PG8_MMA(1, 0, At, B0); PG8_MMA(1, 1, At, B1); PG8_BAR; PG8_SCHED;
            PG8_LDB(B0, 1, 0); PG8_LDB(B1, 1, 1); PG8_SCHED; PG8_LDA(At, 1, 0); PG8_STAGE(PG8_SA(0, 1), a2 + hstepA, voffA);
            PG8_WAIT_V(8); PG8_WAIT_L(0); PG8_BAR; PG8_MMA(0, 0, At, B0); PG8_MMA(0, 1, At, B1); PG8_BAR; PG8_SCHED;
            PG8_LDA(At, 1, 1); PG8_STAGE(PG8_SB(1, 0), b3, voffB); PG8_STAGE(PG8_SB(1, 1), b3 + hstepB, voffB); PG8_STAGE(PG8_SA(1, 0), a3, voffA);
            PG8_WAIT_V(8); PG8_WAIT_L(0); PG8_BAR; PG8_MMA(1, 0, At, B0); PG8_MMA(1, 1, At, B1); PG8_BAR; PG8_SCHED;
            } else {
            PG8_LDB(B0, 0, 0); PG8_SCHED; PG8_LDA(At, 0, 0); PG8_STAGE(PG8_SA(1, 1), a1 + hstepA, voffA);
            PG8_WAIT_L(8); PG8_BAR; PG8_WAIT_L(0); PG8_MMA(0, 0, At, B0); PG8_BAR; PG8_SCHED;
            PG8_LDB(B1, 0, 1); PG8_STAGE(PG8_SB(0, 0), b2, voffB);
            PG8_BAR; PG8_WAIT_L(0); PG8_MMA(0, 1, At, B1); PG8_BAR;
            PG8_LDA(At, 0, 1); PG8_STAGE(PG8_SA(0, 0), a2, voffA);
            PG8_BAR; PG8_WAIT_L(0); PG8_MMA(1, 0, At, B0); PG8_BAR; PG8_SCHED;
            PG8_STAGE(PG8_SB(0, 1), b2 + hstepB, voffB);
            PG8_WAIT_V(6); PG8_BAR; PG8_MMA(1, 1, At, B1); PG8_BAR;
            PG8_LDB(B0, 1, 0); PG8_SCHED; PG8_LDA(At, 1, 0); PG8_STAGE(PG8_SA(0, 1), a2 + hstepA, voffA);
            PG8_WAIT_L(8); PG8_BAR; PG8_WAIT_L(0); PG8_MMA(0, 0, At, B0); PG8_BAR; PG8_SCHED;
            PG8_LDB(B1, 1, 1); PG8_STAGE(PG8_SB(1, 0), b3, voffB);
            PG8_BAR; PG8_WAIT_L(0); PG8_MMA(0, 1, At, B1); PG8_BAR;
            PG8_LDA(At, 1, 1); PG8_STAGE(PG8_SA(1, 0), a3, voffA);
            PG8_BAR; PG8_WAIT_L(0); PG8_MMA(1, 0, At, B0); PG8_BAR; PG8_SCHED;
            PG8_STAGE(PG8_SB(1, 1), b3 + hstepB, voffB);
            PG8_WAIT_V(6); PG8_BAR; PG8_MMA(1, 1, At, B1); PG8_BAR;
            }
        }
        if constexpr (ALIGN_EPI) { if (wr == 0) PG8_BAR; }
        if constexpr (!Epi::AFTER_DRAIN) { E(acc, cur, wr, wc, fr, fq); S.done(cur); }
        if (!has_next) break;
#pragma unroll
        for (int a = 0; a < 2; ++a)
#pragma unroll
            for (int b = 0; b < 2; ++b)
#pragma unroll
                for (int m = 0; m < 4; ++m)
#pragma unroll
                    for (int n = 0; n < 2; ++n) acc[a][b][m][n] = (f32x4){0.f, 0.f, 0.f, 0.f};
        cur = nxt; cA = nA; cB = nB; ++ui;
        if constexpr (ALIGN_EPI) { if (wr == 1) PG8_BAR; }
    }
    PG8_WAIT_V(0);
    if constexpr (!ALIGN_EPI) { if (wr == 0) PG8_BAR; }
    PG8_BAR;
    if constexpr (Epi::AFTER_DRAIN) { E.fused(acc, cur, wr, wc, fr, fq, lds, wid, lane); S.done(cur); }
#undef PG8_SA
#undef PG8_SB
#undef PG8_STAGE
#undef PG8_LDA
#undef PG8_LDB
#undef PG8_MMA
#undef PG8_WAIT_V
#undef PG8_WAIT_L
#undef PG8_BAR
#undef PG8_SCHED
}
}
#include <hip/hip_bf16.h>
#include <cmath>
namespace attn_body {
using bf16=__hip_bfloat16;
using bf16x8=__attribute__((ext_vector_type(8)))short;
using s16x4=__attribute__((ext_vector_type(4)))short;
using f32x16=__attribute__((ext_vector_type(16)))float;
using u32x4=__attribute__((ext_vector_type(4)))unsigned;
using f32x4a=__attribute__((ext_vector_type(4)))float;
constexpr int BATCH=4,NHEAD=16,SEQ=4096,D=64,DM=4096;
constexpr int NW=8,QBLK=32,QB=QBLK*NW,KVBLK=64,NQB=SEQ/QB;
constexpr int ATTN_PITCH=DM, ATTN_UNIT_ROWS=QB;
__device__ __forceinline__ int crow(int r,int hi){return (r&3)+8*(r>>2)+4*hi;}
#define SBAR() __builtin_amdgcn_sched_barrier(0)
__device__ __forceinline__ void cmask(f32x16&p0,f32x16&p1,int jb,int qrel,int hi){
  const float NEG=-INFINITY; int kb=64*jb+4*hi;
  #pragma unroll
  for(int r=0;r<16;++r){int kv=kb+(r&3)+8*(r>>2); if(kv>qrel)p0[r]=NEG; if(kv+32>qrel)p1[r]=NEG;}
}

constexpr int NSLOT=3, SLOTB=8192;
constexpr int LDS_K=0, LDS_V=NSLOT*SLOTB, LDS_WS=2*NSLOT*SLOTB, LDS_OST=LDS_WS+NW*64*4, LDS_CB=LDS_OST+NW*4096, LDS_BYTES=LDS_CB+NW*768;
constexpr float C2=0.125f*1.4426950408889634f;
__device__ __forceinline__ void glds16(const void*gsrc,unsigned lds_dst){unsigned keep;
  asm volatile("s_mov_b32 %0, m0\n\ts_mov_b32 m0, %2\n\ts_nop 0\n\tglobal_load_lds_dwordx4 %1, off\n\ts_mov_b32 m0, %0":"=&s"(keep):"v"(gsrc),"s"(lds_dst):"memory");}
__device__ __forceinline__ void glds4(const void*gsrc,unsigned lds_dst){unsigned keep;
  asm volatile("s_mov_b32 %0, m0\n\ts_mov_b32 m0, %2\n\ts_nop 0\n\tglobal_load_lds_dword %1, off\n\ts_mov_b32 m0, %0":"=&s"(keep):"v"(gsrc),"s"(lds_dst):"memory");}
__device__ __forceinline__ float max3f(float a,float b,float c){float r;asm("v_max3_f32 %0, %1, %2, %3":"=v"(r):"v"(a),"v"(b),"v"(c));return r;}
__device__ __forceinline__ float max2f(float a,float b){float r;asm("v_max_f32_e32 %0, %1, %2":"=v"(r):"v"(a),"v"(b));return r;}
__device__ __forceinline__ float fadd_s(float a,float b){float r;asm("v_add_f32_e32 %0, %1, %2":"=v"(r):"v"(a),"v"(b));return r;}
__device__ __forceinline__ float fsub_s(float a,float b){float r;asm("v_sub_f32_e32 %0, %1, %2":"=v"(r):"v"(a),"v"(b));return r;}
typedef float f32x2_t __attribute__((ext_vector_type(2))); typedef __bf16 bf16x2_t __attribute__((ext_vector_type(2)));
__device__ __forceinline__ unsigned cvtpk_s(float lo,float hi){f32x2_t v={lo,hi};bf16x2_t b=__builtin_convertvector(v,bf16x2_t);return __builtin_bit_cast(unsigned,b);}
#define WAIT_BAR(N) asm volatile("s_waitcnt vmcnt(" #N ") lgkmcnt(0)\n\ts_barrier":::"memory")

__device__ __forceinline__ void qkt(f32x16&p0,f32x16&p1,const char*Kslot,const bf16x8*qr,int r32,int hi){
  const char*kb=Kslot+hi*1024+r32*16;
  #pragma unroll
  for(int d0=0;d0<4;++d0){
    const bf16x8 b0=*reinterpret_cast<const bf16x8*>(kb+d0*2048);
    const bf16x8 b1=*reinterpret_cast<const bf16x8*>(kb+d0*2048+512);
    p0=__builtin_amdgcn_mfma_f32_32x32x16_bf16(b0,qr[d0],p0,0,0,0);p1=__builtin_amdgcn_mfma_f32_32x32x16_bf16(b1,qr[d0],p1,0,0,0);}
}
typedef __attribute__((address_space(3))) const char* lds_cptr;
typedef short v4i16_t __attribute__((ext_vector_type(4)));
__device__ __forceinline__ void kload8(bf16x8*kf,lds_cptr kp){
  kf[0]=*(const __attribute__((address_space(3))) bf16x8*)(kp);      kf[1]=*(const __attribute__((address_space(3))) bf16x8*)(kp+512);
  kf[2]=*(const __attribute__((address_space(3))) bf16x8*)(kp+2048); kf[3]=*(const __attribute__((address_space(3))) bf16x8*)(kp+2560);
  kf[4]=*(const __attribute__((address_space(3))) bf16x8*)(kp+4096); kf[5]=*(const __attribute__((address_space(3))) bf16x8*)(kp+4608);
  kf[6]=*(const __attribute__((address_space(3))) bf16x8*)(kp+6144); kf[7]=*(const __attribute__((address_space(3))) bf16x8*)(kp+6656);
}
__device__ __forceinline__ void kload2(bf16x8*kf,lds_cptr kp,int j){ kf[2*j]=*(const __attribute__((address_space(3))) bf16x8*)(kp+j*2048); kf[2*j+1]=*(const __attribute__((address_space(3))) bf16x8*)(kp+j*2048+512); }
__device__ __forceinline__ s16x4 vtr(lds_cptr p){ return __builtin_bit_cast(s16x4,__builtin_amdgcn_ds_read_tr16_b64_v4i16((__attribute__((address_space(3))) v4i16_t*)p)); }
__device__ __forceinline__ float rowmax(const f32x16&p0,const f32x16&p1){
  float a=max3f(p0[0],p0[1],p1[0]),b=max3f(p0[2],p0[3],p1[1]);a=max3f(a,p1[2],p1[3]);
  #pragma unroll
  for(int r=4;r<16;r+=4){a=max3f(a,p0[r],p0[r+1]);b=max3f(b,p0[r+2],p0[r+3]);a=max3f(a,p1[r],p1[r+1]);b=max3f(b,p1[r+2],p1[r+3]);}
  const float m=max2f(a,b);
  auto rr=__builtin_amdgcn_permlane32_swap(__float_as_uint(m),__float_as_uint(m),false,false);
  return max2f(__uint_as_float(rr[0]),__uint_as_float(rr[1]));
}
__device__ __forceinline__ void pv(f32x16*o,int vb,bf16x8 pa0,bf16x8 pa1,bf16x8 pa2,bf16x8 pa3){
  #pragma unroll
  for(int d0=0;d0<2;++d0){s16x4 lo[4],hi[4];
    #pragma unroll
    for(int ks=0;ks<4;++ks){
      asm volatile("ds_read_b64_tr_b16 %0,%1 offset:%c2":"=&v"(lo[ks]):"v"(vb),"i"(d0*4096+ks*1024):"memory");
      asm volatile("ds_read_b64_tr_b16 %0,%1 offset:%c2":"=&v"(hi[ks]):"v"(vb),"i"(d0*4096+ks*1024+512):"memory");}
    asm volatile("s_waitcnt lgkmcnt(0)":::"memory");SBAR();
    #define PK(k) (bf16x8){lo[k][0],lo[k][1],lo[k][2],lo[k][3],hi[k][0],hi[k][1],hi[k][2],hi[k][3]}
    o[d0]=__builtin_amdgcn_mfma_f32_32x32x16_bf16(pa0,PK(0),o[d0],0,0,0);
    o[d0]=__builtin_amdgcn_mfma_f32_32x32x16_bf16(pa1,PK(1),o[d0],0,0,0);
    o[d0]=__builtin_amdgcn_mfma_f32_32x32x16_bf16(pa2,PK(2),o[d0],0,0,0);
    o[d0]=__builtin_amdgcn_mfma_f32_32x32x16_bf16(pa3,PK(3),o[d0],0,0,0);
    #undef PK
  }
}

#ifndef ATTN_STORE16
#define ATTN_STORE16(p,v) (*(u32x4*)(p)=(v))
#endif
template<int THRL> __device__ __forceinline__ void attn_unit(int b,int h,int qb,const bf16*Q,const bf16*__restrict__ K,const bf16*__restrict__ V,const bf16*__restrict__ G,const float*__restrict__ CF,bf16*O,char*shm,const int wid,const float bnd2  ,const bool do_store=true){
  const int lane=lane_id(),r32=lane&31,hi=lane>>5;
  const long rowbase=(long)b*SEQ; const int q0=qb*QB;
  const bf16*Qw=Q+(rowbase+q0+wid*QBLK)*DM+h*D;
  const float*CFh=CF+(long)(b*NHEAD+h)*SEQ;
  int ts; { const int NT0=(q0+QB)/KVBLK; const float cq0=CFh[q0]; const float ce=CFh[64*(lane<NT0?lane:0)+63];
    const unsigned long long bm=__ballot((lane<NT0-4)&&(cq0-ce+bnd2<-60.f)); ts=__builtin_amdgcn_readfirstlane((int)__builtin_ctzll(~bm))&~1; }
  const bf16*Kh=K+(rowbase+(long)ts*KVBLK)*DM+h*D,*Vh=V+(rowbase+(long)ts*KVBLK)*DM+h*D;
  const unsigned lds0=(unsigned)(uintptr_t)shm;
  float*wsf=(float*)(shm+LDS_WS)+wid*64;
  const bf16*ksrc=Kh+(long)lane*DM+wid*8;
  const bf16*vsrc=Vh+(long)(16*(wid&3)+(lane>>2))*DM+(wid>>2)*32+(lane&3)*8;
  const unsigned kdst=lds0+LDS_K+wid*1024, vdst=lds0+LDS_V+wid*1024, cdst=lds0+LDS_CB+wid*768; const float*csrc=CFh+ts*KVBLK+lane;
  #define DMA_K(t,slot) do{ glds16(ksrc+(long)(t)*KVBLK*DM,(unsigned)__builtin_amdgcn_readfirstlane(kdst+(slot))); glds4(csrc+(t)*KVBLK,(unsigned)__builtin_amdgcn_readfirstlane(cdst+((slot)>>5))); }while(0)
  #define DMA_V(t,slot) glds16(vsrc+(long)(t)*KVBLK*DM,(unsigned)__builtin_amdgcn_readfirstlane(vdst+(slot)))
  const int vb0=(int)(lds0+LDS_V)+((lane>>4)&1)*32+(lane&3)*8+(4*hi+((lane&15)>>2))*64;
  const char*Kbase=shm+LDS_K; bf16x8 kf[8];
  const lds_cptr shm3=(lds_cptr)shm; const lds_cptr kp0=shm3+LDS_K+hi*1024+r32*16; const lds_cptr vp0=shm3+LDS_V+((lane>>4)&1)*32+(lane&3)*8+(4*hi+((lane&15)>>2))*64;
  const int NT=(q0+QB)/KVBLK-ts;
  DMA_K(0,0);DMA_V(0,0);DMA_K(1,SLOTB);
  bf16x8 qr[4];
  #pragma unroll
  for(int d0=0;d0<4;++d0)qr[d0]=*reinterpret_cast<const bf16x8*>(&Qw[(long)r32*DM+d0*16+hi*8]);
  float mhat=0.f,l_reg=0.f;f32x16 o[2];o[0]=f32x16{};o[1]=f32x16{};
  float nb=CFh[q0+wid*QBLK+r32];
  const lds_cptr cbp0=(lds_cptr)shm+LDS_CB+wid*768+hi*16;
  #define CINIT(C0,C1,slot) do{ const lds_cptr cb_=cbp0+((slot)>>5); _Pragma("unroll") for(int g_=0;g_<4;++g_){ \
      const f32x4a a_=*(const __attribute__((address_space(3))) f32x4a*)(cb_+32*g_), b_=*(const __attribute__((address_space(3))) f32x4a*)(cb_+128+32*g_); \
      _Pragma("unroll") for(int i_=0;i_<4;++i_){ C0[4*g_+i_]=nb-a_[i_]; C1[4*g_+i_]=nb-b_[i_]; } } }while(0)
  const int qrel=wid*QBLK+r32;
  #define CMASK(P0,P1,t) do{int jb_=(t)-(NT-4); if(jb_>=0)cmask(P0,P1,jb_,qrel,hi);}while(0)
  bool resc=false;
  #define START(P0,P1) do{ const float rm=rowmax(P0,P1); resc=false; \
    { const float dl=rm; mhat=fadd_s(mhat,dl); \
      _Pragma("unroll") for(int r=0;r<16;++r){P0[r]=fsub_s(P0[r],dl);P1[r]=fsub_s(P1[r],dl);} \
      nb-=dl; } \
    _Pragma("unroll") for(int r=0;r<16;++r)P0[r]=__builtin_amdgcn_exp2f(P0[r]); }while(0)
  #define RESC() do{ if(resc){ asm volatile("s_waitcnt lgkmcnt(0)":::"memory"); \
      _Pragma("unroll") for(int d_=0;d_<2;++d_) _Pragma("unroll") for(int r=0;r<16;++r)o[d_][r]*=wsf[crow(r,hi)]; } }while(0)
  f32x16 pA0,pA1,pB0,pB1;
  int sl_prev=0,sl_cur=0,sl_next=SLOTB;
  #define ROT() do{sl_prev=sl_cur;sl_cur=sl_next;sl_next=(sl_next==(NSLOT-1)*SLOTB)?0:sl_next+SLOTB;}while(0)
  DMA_K(2,2*SLOTB);
  WAIT_BAR(3);
  CINIT(pA0,pA1,0); qkt(pA0,pA1,Kbase,qr,r32,hi);asm volatile("s_nop 15\n\ts_nop 7":"+v"(pA0),"+v"(pA1));CMASK(pA0,pA1,0);
  START(pA0,pA1);
  _Pragma("unroll") for(int r=0;r<16;++r)pA1[r]=__builtin_amdgcn_exp2f(pA1[r]);
  WAIT_BAR(0);
  DMA_K(3,0);DMA_V(1,SLOTB);
  ROT();
  kload8(kf,kp0+sl_cur);
  WAIT_BAR(3);
  s16x4 vlo[8],vhi[8]; u32x4 pw0,pw1,pw2,pw3;
  #define PKW(P,B) cvtpk_s(P[B],P[B+1])
  #define PAF(k) __builtin_bit_cast(bf16x8,pw##k)
  #define VFR(i) (bf16x8){vlo[i][0],vlo[i][1],vlo[i][2],vlo[i][3],vhi[i][0],vhi[i][1],vhi[i][2],vhi[i][3]}
  #define PIN(x) asm volatile("":"+v"(x))
  #define MX3(a,b,c) __builtin_fmaxf(__builtin_fmaxf((a),(b)),(c))
  #define GAPA(MF,A0,A1,A2,A3,W0,W1,PW) do{ MF; sacc+=A0; sacc+=A1; sacc+=A2; sacc+=A3; PIN(sacc); W0; W1; PIN(PW); SBAR(); }while(0)
  #define EX(v) __builtin_amdgcn_exp2f(v)
  #define GAPB(MF,X,B) do{ MF; X[B]=EX(X[B]); X[B+1]=EX(X[B+1]); X[B+2]=EX(X[B+2]); X[B+3]=EX(X[B+3]); PIN(X); SBAR(); }while(0)
  #define VRD(i) do{ vlo[i]=vtr(vp_+(((i)>>2)*4096+((i)&3)*1024)); vhi[i]=vtr(vp_+(((i)>>2)*4096+((i)&3)*1024+512)); }while(0)
  #define KRD(G,j) do{ if(G){ kload2(kf,kp0+sl_next,j); SBAR(); } }while(0)
  #define STEP(C0,C1,P0,P1,t,GK,GV,GL) do{ SBAR(); \
    CINIT(C0,C1,sl_cur); SBAR(); \
    const lds_cptr vp_=vp0+sl_prev; \
    VRD(0); SBAR(); float sacc=(P0[0]+P0[1]); \
    GAPA(C0=__builtin_amdgcn_mfma_f32_32x32x16_bf16(kf[0],qr[0],C0,0,0,0), P0[2],P0[3],P0[4],P0[5],     pw0[0]=PKW(P0,0), pw0[1]=PKW(P0,2), pw0); \
    VRD(4); SBAR(); GAPA(C1=__builtin_amdgcn_mfma_f32_32x32x16_bf16(kf[1],qr[0],C1,0,0,0), P0[6],P0[7],P0[8],P0[9],     pw0[2]=PKW(P0,4), pw0[3]=PKW(P0,6), pw0); \
    VRD(1); SBAR(); GAPA(C0=__builtin_amdgcn_mfma_f32_32x32x16_bf16(kf[2],qr[1],C0,0,0,0),   P0[10],P0[11],P0[12],P0[13], pw1[0]=PKW(P0,8), pw1[1]=PKW(P0,10), pw1); \
    VRD(5); SBAR(); GAPA(C1=__builtin_amdgcn_mfma_f32_32x32x16_bf16(kf[3],qr[1],C1,0,0,0),   P0[14],P0[15],P1[0],P1[1],   pw1[2]=PKW(P0,12),pw1[3]=PKW(P0,14), pw1); \
    VRD(2); SBAR(); GAPA(C0=__builtin_amdgcn_mfma_f32_32x32x16_bf16(kf[4],qr[2],C0,0,0,0),   P1[2],P1[3],P1[4],P1[5],     pw2[0]=PKW(P1,0), pw2[1]=PKW(P1,2), pw2); \
    VRD(6); SBAR(); GAPA(C1=__builtin_amdgcn_mfma_f32_32x32x16_bf16(kf[5],qr[2],C1,0,0,0),   P1[6],P1[7],P1[8],P1[9],     pw2[2]=PKW(P1,4), pw2[3]=PKW(P1,6), pw2); \
    VRD(3); SBAR(); GAPA(C0=__builtin_amdgcn_mfma_f32_32x32x16_bf16(kf[6],qr[3],C0,0,0,0),   P1[10],P1[11],P1[12],P1[13], pw3[0]=PKW(P1,8), pw3[1]=PKW(P1,10), pw3); \
    VRD(7); SBAR(); GAPA(C1=__builtin_amdgcn_mfma_f32_32x32x16_bf16(kf[7],qr[3],C1,0,0,0),   P1[14],P1[15],0.f,0.f,       pw3[2]=PKW(P1,12),pw3[3]=PKW(P1,14), pw3); \
    l_reg+=sacc; \
    if(GK){DMA_K((t)+3,sl_cur);} if(GV){DMA_V((t)+1,sl_next);} \
    CMASK(C0,C1,t); \
    { float a=MX3(C0[0],C0[1],C1[0]),b=MX3(C0[2],C0[3],C1[1]); a=MX3(a,C1[2],C1[3]); \
      _Pragma("unroll") for(int r=4;r<16;r+=4){a=MX3(a,C0[r],C0[r+1]);b=MX3(b,C0[r+2],C0[r+3]);a=MX3(a,C1[r],C1[r+1]);b=MX3(b,C1[r+2],C1[r+3]);} \
      float rm=__builtin_fmaxf(a,b); { auto rr=__builtin_amdgcn_permlane32_swap(__float_as_uint(rm),__float_as_uint(rm),false,false); rm=__builtin_fmaxf(__uint_as_float(rr[0]),__uint_as_float(rr[1])); } \
      resc=false; \
      if(__builtin_expect(__any(rm>(float)THRL),0)){ const float dl=__builtin_fmaxf(rm,0.f); mhat+=dl; \
        _Pragma("unroll") for(int r=0;r<16;++r){C0[r]-=dl;C1[r]-=dl;} \
        nb-=dl; \
        const float f=__builtin_amdgcn_exp2f(-dl); l_reg*=f; if(hi==0)wsf[r32]=f; resc=true; } } \
    SBAR(); \
    GAPB(o[0]=__builtin_amdgcn_mfma_f32_32x32x16_bf16(PAF(0),VFR(0),o[0],0,0,0), C0,0); \
    GAPB(o[1]=__builtin_amdgcn_mfma_f32_32x32x16_bf16(PAF(0),VFR(4),o[1],0,0,0), C0,4); \
    KRD(GL,0); GAPB(o[0]=__builtin_amdgcn_mfma_f32_32x32x16_bf16(PAF(1),VFR(1),o[0],0,0,0), C0,8); \
    KRD(GL,1); GAPB(o[1]=__builtin_amdgcn_mfma_f32_32x32x16_bf16(PAF(1),VFR(5),o[1],0,0,0), C0,12); \
    KRD(GL,2); GAPB(o[0]=__builtin_amdgcn_mfma_f32_32x32x16_bf16(PAF(2),VFR(2),o[0],0,0,0), C1,0); \
    KRD(GL,3); GAPB(o[1]=__builtin_amdgcn_mfma_f32_32x32x16_bf16(PAF(2),VFR(6),o[1],0,0,0), C1,4); \
    GAPB(o[0]=__builtin_amdgcn_mfma_f32_32x32x16_bf16(PAF(3),VFR(3),o[0],0,0,0), C1,8); \
    GAPB(o[1]=__builtin_amdgcn_mfma_f32_32x32x16_bf16(PAF(3),VFR(7),o[1],0,0,0), C1,12); \
    }while(0)
  int t=1;
  #undef CMASK
  #define CMASK(P0,P1,t) do{}while(0)
  for(;t+5<NT;t+=2){
    STEP(pB0,pB1,pA0,pA1,t,true,true,true);     WAIT_BAR(3); RESC(); ROT();
    STEP(pA0,pA1,pB0,pB1,t+1,true,true,true);   WAIT_BAR(3); RESC(); ROT();
  }
  #undef CMASK
  #define CMASK(P0,P1,t) do{int jb_=(t)-(NT-4); if(jb_>=0)cmask(P0,P1,jb_,qrel,hi);}while(0)
  #define ENDW(tt) do{ if((tt)+3<NT){WAIT_BAR(3);} else if((tt)+2<NT){WAIT_BAR(1);} else {WAIT_BAR(0);} }while(0)
  for(;t+1<NT;t+=2){
    STEP(pB0,pB1,pA0,pA1,t,(t+3<NT),(t+1<NT),(t+1<NT));       ENDW(t);   RESC(); ROT();
    STEP(pA0,pA1,pB0,pB1,t+1,(t+4<NT),(t+2<NT),(t+2<NT));     ENDW(t+1); RESC(); ROT();
  }
  STEP(pB0,pB1,pA0,pA1,NT-1,false,false,false); RESC();
  { float sacc=pB0[0]+pB0[1]; _Pragma("unroll") for(int r=2;r<16;++r)sacc+=pB0[r]; _Pragma("unroll") for(int r=0;r<16;++r)sacc+=pB1[r]; l_reg+=sacc;
    pw0=(u32x4){PKW(pB0,0),PKW(pB0,2),PKW(pB0,4),PKW(pB0,6)};pw1=(u32x4){PKW(pB0,8),PKW(pB0,10),PKW(pB0,12),PKW(pB0,14)};pw2=(u32x4){PKW(pB1,0),PKW(pB1,2),PKW(pB1,4),PKW(pB1,6)};pw3=(u32x4){PKW(pB1,8),PKW(pB1,10),PKW(pB1,12),PKW(pB1,14)};
    SBAR(); pv(o,vb0+sl_cur,PAF(0),PAF(1),PAF(2),PAF(3)); }
  #undef PKW
  #undef PAF
  #undef VFR
  #undef PIN
  #undef MX3
  #undef GAPA
  #undef GAPB
  #undef EX
  #undef VRD
  #undef KRD
  #undef STEP
  #undef ENDW
  {auto rr=__builtin_amdgcn_permlane32_swap(__float_as_uint(l_reg),__float_as_uint(l_reg),false,false);l_reg=__uint_as_float(rr[0])+__uint_as_float(rr[1]);}
  if(hi==0)wsf[32+r32]=l_reg;asm volatile("s_waitcnt lgkmcnt(0)":::"memory");
  float rli[16];
  #pragma unroll
  for(int r=0;r<16;++r)rli[r]=__builtin_amdgcn_rcpf(wsf[32+crow(r,hi)]);
  bf16*Ow=O+(rowbase+q0+wid*QBLK)*DM+h*D;
  { bf16*stg=(bf16*)(shm+LDS_OST)+wid*2048;
    #pragma unroll
    for(int r=0;r<16;++r){const int orow=crow(r,hi);
      #pragma unroll
      for(int d0=0;d0<2;++d0)stg[orow*64+d0*32+r32]=__float2bfloat16(o[d0][r]*rli[r]);}
    asm volatile("s_waitcnt lgkmcnt(0)":::"memory");
    const bf16*Gw=G+(rowbase+q0+wid*QBLK)*DM+h*D;
    #pragma unroll
    for(int i=0;i<4;++i){const int row=i*8+(lane>>3),ch=lane&7; const u32x4 v=*(const u32x4*)(stg+row*64+ch*8); const u32x4 gv=*(const u32x4*)(Gw+(long)row*DM+ch*8); u32x4 w;
      #pragma unroll
      for(int e=0;e<4;++e){ const float o0=__uint_as_float(v[e]<<16),o1=__uint_as_float(v[e]&0xffff0000u),g0=__uint_as_float(gv[e]<<16),g1=__uint_as_float(gv[e]&0xffff0000u);
        const float s0=g0*__builtin_amdgcn_rcpf(1.f+__builtin_amdgcn_exp2f(-1.4426950408889634f*g0)),s1=g1*__builtin_amdgcn_rcpf(1.f+__builtin_amdgcn_exp2f(-1.4426950408889634f*g1)); w[e]=cvtpk_s(o0*s0,o1*s1); }
      if(do_store)ATTN_STORE16(Ow+(long)row*DM+ch*8,w);} }
  asm volatile("s_waitcnt lgkmcnt(0)\n\ts_barrier":::"memory");
  #undef DMA_K
  #undef CINIT
  #undef DMA_V
  #undef CMASK
  #undef START
  #undef RESC
  #undef ROT
}
constexpr int ATTN_LDS_BYTES=LDS_BYTES;
#undef SBAR
#undef WAIT_BAR
}
namespace scan2 {
#define S2_LAS __attribute__((address_space(3)))
typedef float f32x4 __attribute__((ext_vector_type(4)));
typedef float f32x2 __attribute__((ext_vector_type(2)));
typedef unsigned u32x2 __attribute__((ext_vector_type(2)));
constexpr int T = 4096, C = 16, NCH = T / C, RS = 272  , R20 = 80  ;
constexpr int O_ALPHA = 0, O_RHO = 4352, O_NBETA = 8704, O_KAPPA = 13056, O_VROW = 17408, O_G15 = 21760, SLOT3 = 22016;
constexpr int O_S2 = 3 * SLOT3, O_KAT = 0, O_NRT = 1280, O_KRT = 2560, O_NN = 3840  , O_NNT = 5120  , SLOT2 = 6400;
constexpr int O_WTOT = O_S2 + 2 * SLOT2  , O_YB = O_WTOT + 2048  ;
constexpr int O_PB4 = O_YB + 8192  , PB4 = 8256, O_END = O_PB4 + 4 * PB4, LDS_BYTES = O_END;
template <int CTRL> __device__ __forceinline__ float dppf(float x) { return __builtin_bit_cast(float, __builtin_amdgcn_mov_dpp(__builtin_bit_cast(int, x), CTRL, 0xF, 0xF, true)); }
__device__ __forceinline__ float red16(float x) { x += dppf<0xB1>(x); x += dppf<0x4E>(x); x += dppf<0x141>(x); x += dppf<0x140>(x); return x; }
__device__ __forceinline__ f32x4 bf4(u32x2 u) { return (f32x4){__uint_as_float(u.x << 16), __uint_as_float(u.x & 0xffff0000u), __uint_as_float(u.y << 16), __uint_as_float(u.y & 0xffff0000u)}; }
__device__ __forceinline__ float dot4(f32x4 a, f32x4 b) { return (a.x * b.x + a.y * b.y) + (a.z * b.z + a.w * b.w); }
__device__ __forceinline__ unsigned pkbf(float lo, float hi) { typedef __bf16 b2 __attribute__((ext_vector_type(2))); f32x2 v = {lo, hi}; return __builtin_bit_cast(unsigned, __builtin_convertvector(v, b2)); }
#define S2_MFMA(a, b, c) __builtin_amdgcn_mfma_f32_16x16x4f32((a), (b), (c), 0, 0, 0)
#define S2_LD4(off) (*(const S2_LAS f32x4*)(lds + (off)))
#define S2_LD1(off) (*(const S2_LAS float*)(lds + (off)))
struct Params { const unsigned short* ZRW; const unsigned short* DEC; const unsigned short* AG; unsigned short* YR; const float* mu; const float* k_k; const float* k_a; const float* r_k; const float* ln_g; const float* ln_b; };
struct Raw { u32x2 zr, zk, zv, zg, pr, pk, pv, pg, ag, dech; };

__device__ __forceinline__ void scan_head(S2_LAS unsigned char* lds, const Params& P, int bh, const int wid, unsigned long long* tsout = nullptr) {
    unsigned long long twait = 0;
    const int lane = lane_id(), li = lane & 15, lg = lane >> 4;
    const int b = bh >> 4, h = bh & 15;
#define S2_BAR() do { const unsigned long long t0_ = tsout ? __builtin_amdgcn_s_memrealtime() : 0ull; __syncthreads(); if (tsout) twait += __builtin_amdgcn_s_memrealtime() - t0_; } while (0)
    __syncthreads();
    if (wid < 4) {
        const int wv = wid, t = 4 * wid + lg, c4 = li, colh = h * 64 + 4 * c4;
        const f32x4 lng = *(const f32x4*)(P.ln_g + colh), lnb = *(const f32x4*)(P.ln_b + colh);
        f32x4 St[4] = {{0.f, 0.f, 0.f, 0.f}, {0.f, 0.f, 0.f, 0.f}, {0.f, 0.f, 0.f, 0.f}, {0.f, 0.f, 0.f, 0.f}};
#define S2_POST(cc) do { const int po = O_PB4 + ((cc) & 3) * PB4; \
        const f32x4 y4 = S2_LD4(O_YB + ((cc) & 1) * 4096 + t * 256 + c4 * 16); \
        const float mean = red16((y4.x + y4.y) + (y4.z + y4.w)) * (1.f / 64.f); const f32x4 d = y4 - mean; \
        const float var = red16(dot4(d, d)) * (1.f / 64.f); const float rs_ = __builtin_amdgcn_rsqf(var + 64e-5f); \
        const f32x4 v4 = S2_LD4(po + t * 256 + c4 * 16), gs4 = S2_LD4(po + 4096 + t * 256 + c4 * 16); const float kb = S2_LD1(po + 8192 + t * 4); \
        f32x4 sg4; _Pragma("unroll") for (int e = 0; e < 4; ++e) sg4[e] = gs4[e] * __builtin_amdgcn_rcpf(1.f + __builtin_amdgcn_exp2f(-1.4426950408889634f * gs4[e])); \
        const f32x4 o = ((d * rs_) * lng + lnb + kb * v4) * sg4; \
        const size_t m_ = (size_t)b * T + (cc) * C + t; \
        *(u32x2*)(P.YR + m_ * 1024 + colh) = (u32x2){pkbf(o.x, o.y), pkbf(o.z, o.w)}; } while (0)
        __syncthreads(); __syncthreads(); __syncthreads();
        int s3 = 0;
        const int cb = li & 7, bb = li >> 3; const bool lo8 = li < 8, g01 = lg < 2;
        f32x4 dl; _Pragma("unroll") for (int ks = 0; ks < 4; ++ks) dl[ks] = (li == 4 * lg + ks) ? 1.f : 0.f;
#pragma unroll 1
        for (int c = 0; c < NCH; ++c) {
            const int so = s3 * SLOT3, s2o = O_S2 + (c & 1) * SLOT2;
            f32x4 RH = {0.f, 0.f, 0.f, 0.f}, Y0 = RH, Ut = RH;
            float Tb[8];
            {
                f32x4 al[4], ro[4];
#pragma unroll
                for (int kb = 0; kb < 4; ++kb) { al[kb] = S2_LD4(so + O_ALPHA + li * RS + (16 * kb + 4 * lg) * 4); ro[kb] = S2_LD4(so + O_RHO + li * RS + (16 * kb + 4 * lg) * 4); }
#pragma unroll
                for (int idx = 0; idx < 16; ++idx) { const int kb = idx >> 2, r = idx & 3;
                    RH = S2_MFMA(al[kb][r], St[kb][r], RH); Y0 = S2_MFMA(ro[kb][r], St[kb][r], Y0);
                    if (idx < 8) { const int i_ = 7 - idx; float a0 = 0.f, a1 = 0.f;
                        if (i_ < 7) { const f32x4 n1 = S2_LD4(s2o + O_NN + (8 * bb + i_) * R20 + (8 * bb + 4) * 4);
#pragma unroll
                            for (int e = 0; e < 4; ++e) if (4 + e > i_) a1 += n1[e] * Tb[4 + e]; }
                        if (i_ < 3) { const f32x4 n0 = S2_LD4(s2o + O_NN + (8 * bb + i_) * R20 + (8 * bb) * 4);
#pragma unroll
                            for (int e = 0; e < 4; ++e) if (e > i_) a0 += n0[e] * Tb[e]; }
                        Tb[i_] = ((cb == i_) ? 1.f : 0.f) - (a0 + a1); } }
            }
            f32x4 qa, qb, qc;
            { const f32x4 nnt = S2_LD4(s2o + O_NNT + li * R20 + lg * 16);
#pragma unroll
              for (int ks = 0; ks < 4; ++ks) { const unsigned mk_ = 0u - (unsigned)(lg & 1); const float sel = __uint_as_float((__float_as_uint(Tb[4 + ks]) & mk_) | (__float_as_uint(Tb[ks]) & ~mk_));
                  qa[ks] = lo8 ? (g01 ? sel : 0.f) : dl[ks]; qc[ks] = lo8 ? dl[ks] : (g01 ? 0.f : sel); qb[ks] = (!lo8 && g01) ? nnt[ks] : dl[ks]; } }
            const f32x4 kaT = S2_LD4(s2o + O_KAT + li * R20 + lg * 16), nrT = S2_LD4(s2o + O_NRT + li * R20 + lg * 16), krT = S2_LD4(s2o + O_KRT + li * R20 + lg * 16);
            f32x4 vv;
#pragma unroll
            for (int ks = 0; ks < 4; ++ks) vv[ks] = S2_LD1(so + O_VROW + (4 * lg + ks) * RS + (16 * wv + li) * 4);
#pragma unroll
            for (int ks = 0; ks < 4; ++ks) RH = S2_MFMA(kaT[ks], vv[ks], RH);
            { f32x4 X1 = {0.f, 0.f, 0.f, 0.f}, X2 = X1;
#pragma unroll
              for (int ks = 0; ks < 4; ++ks) X1 = S2_MFMA(qa[ks], RH[ks], X1);
#pragma unroll
              for (int ks = 0; ks < 4; ++ks) X2 = S2_MFMA(qb[ks], X1[ks], X2);
#pragma unroll
              for (int ks = 0; ks < 4; ++ks) Ut = S2_MFMA(qc[ks], X2[ks], Ut); }
#pragma unroll
            for (int ks = 0; ks < 4; ++ks) { Y0 = S2_MFMA(nrT[ks], Ut[ks], Y0); Y0 = S2_MFMA(krT[ks], vv[ks], Y0); }
            {
                S2_LAS unsigned char* yb = lds + O_YB + (c & 1) * 4096 + (16 * wv + li) * 4;
#pragma unroll
                for (int r = 0; r < 4; ++r) *(S2_LAS float*)(yb + (4 * lg + r) * 256) = Y0[r];
            }
            {
                f32x4 nb[4], kq[4];
#pragma unroll
                for (int kb = 0; kb < 4; ++kb)
#pragma unroll
                    for (int ks = 0; ks < 4; ++ks) { nb[kb][ks] = S2_LD1(so + O_NBETA + (4 * lg + ks) * RS + (16 * kb + li) * 4); kq[kb][ks] = S2_LD1(so + O_KAPPA + (4 * lg + ks) * RS + (16 * kb + li) * 4); }
#pragma unroll
                for (int ks = 0; ks < 4; ++ks) {
#pragma unroll
                    for (int kb = 0; kb < 4; ++kb) St[kb] = S2_MFMA(nb[kb][ks], Ut[ks], St[kb]);
#pragma unroll
                    for (int kb = 0; kb < 4; ++kb) St[kb] = S2_MFMA(kq[kb][ks], vv[ks], St[kb]); }
                if (c >= 1) S2_POST(c - 1);
#pragma unroll
                for (int kb = 0; kb < 4; ++kb) St[kb] = St[kb] * S2_LD4(so + O_G15 + (16 * kb + 4 * lg) * 4);
            }
            s3 = (s3 == 2) ? 0 : s3 + 1;
            S2_BAR();
        }
        S2_POST(NCH - 1);
#undef S2_POST
        if (tsout && wid == 0 && lane == 0) { tsout[20] = twait; tsout[23] = 0ull; }
    } else {
        const int p = wid - 4, t = 4 * p + lg, c4 = li, colh = h * 64 + 4 * c4;
        const f32x4 mu_r = *(const f32x4*)(P.mu + colh), mu_k = *(const f32x4*)(P.mu + 1024 + colh), mu_v = *(const f32x4*)(P.mu + 2048 + colh), mu_g = *(const f32x4*)(P.mu + 3072 + colh);
        const f32x4 kkc = *(const f32x4*)(P.k_k + colh), kac = *(const f32x4*)(P.k_a + colh), rkc = *(const f32x4*)(P.r_k + colh);
        Raw R0, R1, R2;
        f32x4 ginC, gexC, ginN, gexN;
#define S2_LOAD(k, R) do { const int kk_ = (k) < NCH ? (k) : NCH - 1; const int t_ = kk_ * C + t; const size_t m_ = (size_t)b * T + t_; const unsigned short* z_ = P.ZRW + m_ * 4096 + colh; \
        R.zr = *(const u32x2*)(z_); R.zk = *(const u32x2*)(z_ + 1024); R.zv = *(const u32x2*)(z_ + 2048); R.zg = *(const u32x2*)(z_ + 3072); \
        if (t_ > 0) { R.pr = *(const u32x2*)(z_ - 4096); R.pk = *(const u32x2*)(z_ - 4096 + 1024); R.pv = *(const u32x2*)(z_ - 4096 + 2048); R.pg = *(const u32x2*)(z_ - 4096 + 3072); } \
        else { R.pr = (u32x2){0u, 0u}; R.pk = R.pr; R.pv = R.pr; R.pg = R.pr; } \
        R.dech = *(const u32x2*)(P.DEC + m_ * 1024 + colh); R.ag = *(const u32x2*)(P.AG + m_ * 1024 + colh); } while (0)
#define S2_W(k, R, gin, gex) do { typedef _Float16 h4_ __attribute__((ext_vector_type(4))); const h4_ dh_ = __builtin_bit_cast(h4_, R.dech); \
        gin = (f32x4){1.f - (float)dh_[0], 1.f - (float)dh_[1], 1.f - (float)dh_[2], 1.f - (float)dh_[3]}; \
        { f32x4 y_; _Pragma("unroll") for (int e = 0; e < 4; ++e) y_[e] = __shfl_up(gin[e], 16); if (lg >= 1) gin = gin * y_; \
          _Pragma("unroll") for (int e = 0; e < 4; ++e) y_[e] = __shfl_up(gin[e], 32); if (lg >= 2) gin = gin * y_; } \
        _Pragma("unroll") for (int e = 0; e < 4; ++e) gex[e] = __shfl_up(gin[e], 16); if (lg == 0) gex = (f32x4){1.f, 1.f, 1.f, 1.f}; \
        if (lg == 3) *(S2_LAS f32x4*)(lds + O_WTOT + ((k) & 1) * 1024 + p * 256 + c4 * 16) = gin; } while (0)
#define S2_A(k, s3k, R, gin, gex) do { const int so = (s3k) * SLOT3, po = O_PB4 + ((k) & 3) * PB4; \
        const f32x4 r_ = bf4(R.zr), k_ = bf4(R.zk), v_ = bf4(R.zv), g_ = bf4(R.zg); \
        const f32x4 rs = r_ + (bf4(R.pr) - r_) * mu_r, ks = k_ + (bf4(R.pk) - k_) * mu_k, vs = v_ + (bf4(R.pv) - v_) * mu_v, gs = g_ + (bf4(R.pg) - g_) * mu_g; \
        const f32x4 kkr = ks * kkc; const float n2 = red16(dot4(kkr, kkr)); const float inv = fminf(__builtin_amdgcn_rsqf(n2), 1e12f); const f32x4 kk = kkr * inv; \
        const f32x4 a_ = bf4(R.ag), kp = ks * (1.f + (a_ - 1.f) * kac), bv = kk * a_; \
        const float kb = red16(dot4(rs * kp, rkc)); \
        f32x4 gb = {1.f, 1.f, 1.f, 1.f}; for (int q_ = 0; q_ < p; ++q_) gb = gb * S2_LD4(O_WTOT + ((k) & 1) * 1024 + q_ * 256 + c4 * 16); \
        const f32x4 gm = gb * gin, gp = gb * gex; \
        f32x4 gi; _Pragma("unroll") for (int e = 0; e < 4; ++e) gi[e] = __builtin_amdgcn_rcpf(gm[e]); \
        *(S2_LAS f32x4*)(lds + so + O_ALPHA + t * RS + c4 * 16) = gp * kk; *(S2_LAS f32x4*)(lds + so + O_RHO + t * RS + c4 * 16) = gm * rs; \
        *(S2_LAS f32x4*)(lds + so + O_NBETA + t * RS + c4 * 16) = -(bv * gi); *(S2_LAS f32x4*)(lds + so + O_KAPPA + t * RS + c4 * 16) = kp * gi; \
        *(S2_LAS f32x4*)(lds + so + O_VROW + t * RS + c4 * 16) = vs; *(S2_LAS f32x4*)(lds + po + t * 256 + c4 * 16) = vs; *(S2_LAS f32x4*)(lds + po + 4096 + t * 256 + c4 * 16) = gs;     \
        if (c4 == 0) *(S2_LAS float*)(lds + po + 8192 + t * 4) = kb; if (t == C - 1) *(S2_LAS f32x4*)(lds + so + O_G15 + c4 * 16) = gm; } while (0)
#define S2_M1(k, s3k) do { const int so = (s3k) * SLOT3, s2o = O_S2 + ((k) & 1) * SLOT2; \
        f32x4 D = {0.f, 0.f, 0.f, 0.f}, D2 = D; const int xo = so + ((p < 2) ? O_NBETA : O_KAPPA) + li * RS + lg * 16, yo = so + ((p & 1) ? O_RHO : O_ALPHA) + li * RS + lg * 16; \
        _Pragma("unroll") for (int kb_ = 0; kb_ < 4; ++kb_) { const f32x4 xa = S2_LD4(xo + kb_ * 64), yb = S2_LD4(yo + kb_ * 64); \
            D = S2_MFMA(xa[0], yb[0], D); D2 = S2_MFMA(xa[1], yb[1], D2); D = S2_MFMA(xa[2], yb[2], D); D2 = S2_MFMA(xa[3], yb[3], D2); } \
        D = D + D2;     \
        f32x4 o; _Pragma("unroll") for (int r = 0; r < 4; ++r) { const int i_ = 4 * lg + r; const bool keep = (p & 1) ? (i_ <= li) : (i_ < li); o[r] = keep ? D[r] : 0.f; } \
        if (p == 0) { _Pragma("unroll") for (int r = 0; r < 4; ++r) *(S2_LAS float*)(lds + s2o + O_NN + (4 * lg + r) * R20 + li * 4) = -o[r]; *(S2_LAS f32x4*)(lds + s2o + O_NNT + li * R20 + lg * 16) = o; } \
        else *(S2_LAS f32x4*)(lds + s2o + ((p == 1) ? O_NRT : (p == 2) ? O_KAT : O_KRT) + li * R20 + lg * 16) = o; } while (0)
        S2_LOAD(0, R0); S2_LOAD(1, R1); S2_LOAD(2, R2);
        S2_W(0, R0, ginC, gexC); S2_W(1, R1, ginN, gexN);
        __syncthreads();
        S2_A(0, 0, R0, ginC, gexC); S2_A(1, 1, R1, ginN, gexN); S2_LOAD(3, R0);
        __syncthreads();
        S2_M1(0, 0); S2_W(2, R2, ginC, gexC);
        __syncthreads();
#define S2_INTERVAL(c, sA, sM, RA, RW, RL) do { \
        if ((c) + 1 < NCH) S2_M1((c) + 1, sM); \
        if ((c) + 2 < NCH) S2_A((c) + 2, sA, RA, ginC, gexC); \
        S2_W((c) + 3, RW, ginN, gexN); ginC = ginN; gexC = gexN; \
        S2_LOAD((c) + 4, RL); \
        S2_BAR(); } while (0)
#pragma unroll 1
        for (int c = 0; c < NCH; c += 3) {
            S2_INTERVAL(c, 2, 1, R2, R0, R1);
            if (c + 1 < NCH) S2_INTERVAL(c + 1, 0, 2, R0, R1, R2);
            if (c + 2 < NCH) S2_INTERVAL(c + 2, 1, 0, R1, R2, R0);
        }
        if (tsout && wid == 4 && lane == 0) { tsout[21] = twait; tsout[22] = 0ull; }
#undef S2_LOAD
#undef S2_W
#undef S2_A
#undef S2_M1
#undef S2_INTERVAL
    }
#undef S2_BAR
}
}
#include <hip/hip_cooperative_groups.h>
namespace cg = cooperative_groups;
#ifndef MK_PER_PHASE_LAUNCHES
#define MK_PER_PHASE_LAUNCHES 0
#endif
constexpr int NWAVES = 8, NTHREADS = NWAVES * 64;
constexpr int BATCH = 4, T = 4096, D = 2048, M = BATCH * T, C = 1024, H = 16, PLE = 256;
constexpr int N_IN = 12432, NZ = 12544;
constexpr float NORM_EPS = 1e-6f;
constexpr size_t MiB = 1u << 20;
constexpr size_t WS_CTL = 0, CTL_ZERO_BYTES = 18432;
constexpr int CW_BAR = 1024, CW_QHEAD = 0, CW_RESTDONE = 64, CW_ATTNDONE = 128, CW_NRM = 512  , CW_CUM = 704  ;
constexpr size_t WS_WIN = 1 * MiB, WS_WUPR = 50 * MiB, WS_WUPF = 54 * MiB, WS_WO = 58 * MiB, WS_WGATE = 66 * MiB, WS_WPLE = 74 * MiB, WS_WLORA = 75 * MiB;
constexpr size_t WS_ZRW = 76 * MiB, WS_ZFX = 204 * MiB, WS_ZG = 332 * MiB, WS_ZS = 460 * MiB, WS_LA = 476 * MiB, WS_CF = 492 * MiB, WS_SS1 = 493 * MiB, WS_SS2 = 495 * MiB, WS_PB = 497 * MiB, WS_FL = 505 * MiB, WS_END = 506 * MiB;
constexpr size_t WS_YR = WS_ZS;
constexpr size_t WS_T1 = WS_ZRW, WS_MG = WS_ZRW + 64 * MiB;
constexpr size_t WS_X1 = WS_ZFX, WS_X1B = WS_ZG, WS_PLE = WS_ZG + 64 * MiB;
constexpr size_t OUT_H = 0, OUT_DEC = 64 * MiB, OUT_AG = 96 * MiB, OUT_T1 = 0;
static_assert(WS_WIN + (size_t)NZ * D * 2 <= WS_WUPR && WS_ZS + (size_t)M * 256 * 4 <= WS_LA && WS_YR + (size_t)M * C * 2 <= WS_CF && WS_LA + (size_t)M * 256 * 2 <= WS_CF && WS_CF + (size_t)BATCH * H * T * 4 <= WS_SS1 && WS_SS1 + (size_t)M * 32 * 4 <= WS_SS2, "d_ws map");
constexpr int LDS_BYTES = 147456, MISC_OFF = LDS_BYTES - 256, RING_BYTES = MISC_OFF;
static_assert(WS_ZFX - WS_ZRW == WS_ZG - WS_ZFX, "EpiZ segment stride");
static_assert(scan2::LDS_BYTES <= RING_BYTES && attn_body::ATTN_LDS_BYTES <= RING_BYTES, "phase scratch fits the ring region");

#define GAS __attribute__((address_space(1)))
#define LAS __attribute__((address_space(3)))
typedef unsigned short bf16;
typedef unsigned v4u __attribute__((ext_vector_type(4)));
typedef unsigned v2u __attribute__((ext_vector_type(2)));
typedef float f32x4 __attribute__((ext_vector_type(4)));
__device__ __forceinline__ unsigned f2bf(float f) { unsigned u = __builtin_bit_cast(unsigned, f); return (u + 0x7fffu + ((u >> 16) & 1u)) >> 16; }
__device__ __forceinline__ unsigned pk2(float lo, float hi) { return f2bf(lo) | (f2bf(hi) << 16); }
__device__ __forceinline__ float wave_sum(float v) {
#pragma unroll
    for (int o = 1; o < 64; o <<= 1) v += __shfl_xor(v, o);
    return v;
}
#define RLX_AGENT __ATOMIC_RELAXED, __HIP_MEMORY_SCOPE_AGENT
#define LDS_WAIT() asm volatile("s_waitcnt lgkmcnt(0)" ::: "memory")
#define VM_WAIT() asm volatile("s_waitcnt vmcnt(0)" ::: "memory")
__device__ __forceinline__ unsigned long long rt() { return __builtin_amdgcn_s_memrealtime(); }
#define XB_TMO      128
#define XB_XCNT(j)  (256  + 64 * (j))
#define XB_XSUB(j)  (1280 + 64 * (j))
#define XB_XGEN(j)  (2304 + 64 * (j))
#define XB_TOP      3328
#define XB_TOPGEN   3392
#define XCD_BAR_WORDS 3456
#define XB_SPIN_CAP (1u << 18)

__device__ __forceinline__ unsigned xb_ld(unsigned* p)              { return __hip_atomic_load(p, __ATOMIC_RELAXED, __HIP_MEMORY_SCOPE_AGENT); }
__device__ __forceinline__ unsigned xb_add(unsigned* p, unsigned v) { return __hip_atomic_fetch_add(p, v, __ATOMIC_RELAXED, __HIP_MEMORY_SCOPE_AGENT); }
__device__ __forceinline__ unsigned xb_xcc_id() { return (unsigned)__builtin_amdgcn_s_getreg((3 << 11) | 20) & 0xFu; }
#define XB_SPIN(cond, bar) do { unsigned _sp = 0; while (cond) { __builtin_amdgcn_s_sleep(1); \
    if ((++_sp & 255u) == 0u) { if (xb_ld(&(bar)[XB_TMO])) break; if (_sp > XB_SPIN_CAP) { atomicAdd(&(bar)[XB_TMO], 1u); break; } } } } while (0)

struct XcdBarrier {
    unsigned* bar; unsigned x;
    volatile LAS unsigned* st;
};

__device__ __forceinline__ XcdBarrier xcd_barrier_post(unsigned* bar, volatile LAS unsigned* st, bool leader) {
    XcdBarrier b; b.bar = bar; b.x = xb_xcc_id(); b.st = st;
    if (leader) (void)xb_add(&bar[XB_XCNT(b.x)], 1u);
    return b;
}
__device__ __forceinline__ void xcd_barrier_complete(unsigned* bar, unsigned x, unsigned& nloc, unsigned& nx) {
    const unsigned G = gridDim.x * gridDim.y * gridDim.z;
    unsigned sum, cnt, mine, sp = 0u;
    for (;;) {
        sum = 0u; cnt = 0u; mine = 0u;
#pragma unroll
        for (unsigned j = 0; j < 16; ++j) { const unsigned c = xb_ld(&bar[XB_XCNT(j)]); sum += c; cnt += (c > 0u) ? 1u : 0u; mine = (j == x) ? c : mine; }
        if (sum == G) break;
        __builtin_amdgcn_s_sleep(1);
        if ((++sp & 255u) == 0u) { if (xb_ld(&bar[XB_TMO])) break; if (sp > XB_SPIN_CAP) { atomicAdd(&bar[XB_TMO], 1u); break; } }
    }
    nloc = mine > 0u ? mine : 1u; nx = cnt > 0u ? cnt : 1u;
}

__device__ __forceinline__ void xcd_barrier(const XcdBarrier& b, bool leader  ) {
    asm volatile("s_waitcnt vmcnt(0)" ::: "memory");
    __syncthreads();
    if (leader) {
        unsigned* bar = b.bar;
        __builtin_amdgcn_s_waitcnt(0);
        unsigned nloc = b.st[0], nx = b.st[1];
        if (nloc == 0u) { xcd_barrier_complete(bar, b.x, nloc, nx); b.st[0] = nloc; b.st[1] = nx; }
        const unsigned old = xb_add(&bar[XB_XSUB(b.x)], 1u);
        const unsigned gen = old / nloc;
        if (old + 1u == (gen + 1u) * nloc) {
            __builtin_amdgcn_fence(__ATOMIC_RELEASE, "agent");
            asm volatile("s_waitcnt vmcnt(0)" ::: "memory");
            const unsigned og = xb_add(&bar[XB_TOP], 1u);
            const unsigned tg = og / nx;
            if (og + 1u == (tg + 1u) * nx) xb_add(&bar[XB_TOPGEN], 1u);
            else XB_SPIN(xb_ld(&bar[XB_TOPGEN]) == tg, bar);
            __builtin_amdgcn_fence(__ATOMIC_ACQUIRE, "agent");
            xb_add(&bar[XB_XGEN(b.x)], 1u);
            asm volatile("s_waitcnt vmcnt(0)" ::: "memory");
        } else {
            XB_SPIN(xb_ld(&bar[XB_XGEN(b.x)]) == gen, bar);
            __builtin_amdgcn_fence(__ATOMIC_ACQUIRE, "agent");
            asm volatile("s_waitcnt vmcnt(0)" ::: "memory");
        }
    }
    __syncthreads();
}

__device__ __forceinline__ void tr_item(const float* W, int ldw, int n0, int cnt, bf16* WT, int ldt, int row_off, const float* ksc, LAS float* scr, int item, int nblk, int lane) {
    const int kb = item / nblk, nb = item % nblk, k0 = 64 * kb, nn0 = 32 * nb;
#pragma unroll 8
    for (int i = 0; i < 32; ++i) { const int kk = 2 * i + (lane >> 5), n = nn0 + (lane & 31); float v = (n < cnt) ? W[(size_t)(k0 + kk) * ldw + n0 + n] : 0.f; if (ksc) v *= ksc[k0 + kk]; scr[kk * 33 + (lane & 31)] = v; }
    asm volatile("s_waitcnt lgkmcnt(0)" ::: "memory");
    const int c = lane & 7;
#pragma unroll
    for (int j = 0; j < 4; ++j) { const int n = (lane >> 3) + 8 * j; const LAS float* s = scr + (8 * c) * 33 + n;
        v4u o; o.x = pk2(s[0 * 33], s[1 * 33]); o.y = pk2(s[2 * 33], s[3 * 33]); o.z = pk2(s[4 * 33], s[5 * 33]); o.w = pk2(s[6 * 33], s[7 * 33]);
        *(v4u*)(WT + (size_t)(row_off + nn0 + n) * ldt + k0 + 8 * c) = o; }
    asm volatile("s_waitcnt lgkmcnt(0)" ::: "memory");
}
__device__ __forceinline__ void tr_wg_item(const float* W, int ldw, int n0, int cnt, bf16* WT, int ldt, int row_off, const float* ksc, LAS unsigned char* scr, int item, int nblk, int tid) {
    const int kb = item / nblk, nb = item % nblk, k0 = 256 * kb, nn0 = 64 * nb, c = tid & 15, kr = tid >> 4;
    const bool live = (nn0 + 4 * c) < cnt;
#pragma unroll
    for (int ps = 0; ps < 4; ++ps) { const int k = 64 * ps + 2 * kr; f32x4 a = {0.f, 0.f, 0.f, 0.f}, b = a;
        if (live) { const float* src = W + (size_t)(k0 + k) * ldw + n0 + nn0 + 4 * c; a = __builtin_nontemporal_load((const f32x4*)src); b = __builtin_nontemporal_load((const f32x4*)(src + ldw)); }
        if (ksc) { a = a * ksc[k0 + k]; b = b * ksc[k0 + k + 1]; }
        const int kp = k >> 1, j = kp >> 2, w = kp & 3;
#pragma unroll
        for (int i = 0; i < 4; ++i) { const int n = 4 * c + i; *(LAS unsigned*)(scr + n * 512 + ((j ^ c) & 31) * 16 + w * 4) = pk2(a[i], b[i]); } }
    __syncthreads();
    { const int n = tid >> 3;
#pragma unroll
      for (int i = 0; i < 4; ++i) { const int j = (tid & 7) + 8 * i; const v4u v = *(const LAS v4u*)(scr + n * 512 + ((j ^ (n >> 2)) & 31) * 16);
          *(v4u*)(WT + (size_t)(row_off + nn0 + n) * ldt + k0 + 8 * j) = v; } }
    __syncthreads();
}
struct SubOrder {
    pg8::StaticOrder base; int off, brk, jump;
    __device__ void init(int M_, int ntiles, int Gs, int cs, int off_, int brk_, int jump_) { base.init(M_, ntiles * 256, Gs, cs); off = off_; brk = brk_; jump = jump_; }
    __device__ bool next(int i, pg8::Unit& u) const { if (!base.next(i, u)) return false; u.pn = u.pn + off + (u.pn >= brk ? jump : 0); return true; }
    __device__ __forceinline__ void a_ready(const pg8::Unit&) const {}
    __device__ __forceinline__ void done(const pg8::Unit&) const {}
};
struct P1Order { SubOrder A, B; bool hasB;
    __device__ bool next(int i, pg8::Unit& u) const { if (i < 4) return A.next(i, u); if (i == 4) return hasB ? B.next(0, u) : A.next(4, u); return false; }
    __device__ __forceinline__ void a_ready(const pg8::Unit&) const {} __device__ __forceinline__ void done(const pg8::Unit&) const {} };
struct RestOrder { SubOrder B;
    __device__ bool next(int i, pg8::Unit& u) const { return B.next(i + 1, u); }
    __device__ __forceinline__ void a_ready(const pg8::Unit&) const {} __device__ __forceinline__ void done(const pg8::Unit&) const {} };
struct PleOrder { int c;
    __device__ __forceinline__ bool next(int i, pg8::Unit& u) const { const int n = (c < 128) ? 2 : 4; if (i >= n) return false; const int t = (c < 128) ? 2 * c + i : 256 + 4 * (c - 128) + i; u.pm = t >> 3; u.pn = t & 7; return true; }
    __device__ __forceinline__ void a_ready(const pg8::Unit&) const {} __device__ __forceinline__ void done(const pg8::Unit&) const {} };
struct PairOrder { int c; bool pair; pg8::StaticOrder base;
    __device__ __forceinline__ bool next(int i, pg8::Unit& u) const { if (!pair) return base.next(i, u); if (i >= 2) return false; u.pm = 8 * (c & 7) + ((c >> 3) & 7); u.pn = 2 * (c >> 6) + i; return true; }
    __device__ __forceinline__ void a_ready(const pg8::Unit&) const {} __device__ __forceinline__ void done(const pg8::Unit&) const {} };
struct Args { const float* in[22]; float* out; unsigned char* ws; int ph_lo, ph_hi; };
enum { I_X = 0, I_P, I_NORMG, I_WIN, I_MU, I_W0, I_WLORA, I_A0, I_ALORA, I_KK, I_KA, I_RK, I_LNG, I_LNB, I_BF, I_WUPR, I_WUPF, I_WOUT, I_PLEPROJ, I_PLEGATE, I_PLENORMG, I_FINALG };
constexpr int N_PHASES = 10;

__global__ void __launch_bounds__(NTHREADS, 2) mk_fwd(Args args) {
    extern __shared__ __attribute__((aligned(16))) unsigned char lds[];
    LAS unsigned char* const L = (LAS unsigned char*)lds;
    const int wave = __builtin_amdgcn_readfirstlane(threadIdx.x >> 6);
    const int G = gridDim.x, bx = blockIdx.x, vcu = (G % 8 == 0) ? (bx % 8) * (G / 8) + bx / 8 : bx;
    const int gw = vcu * NWAVES + wave, NGW = G * NWAVES;
#define LANE_HERE const int lane = lane_id()
    unsigned char* const ws = args.ws; unsigned char* const ob = (unsigned char*)args.out;
    const int lo = args.ph_lo, hi = args.ph_hi;
#ifndef PROBE_TS_A
#define PROBE_TS_A -1
#define PROBE_TS_B -1
#endif
#ifndef PROBE_TS_OFF
#define PROBE_TS_OFF 0.f
#endif
#define TS_STAMP(i) do { if (PROBE_TS_A >= 0 && wave == 0 && lane_id() == 0) __hip_atomic_store((unsigned long long*)(ws + WS_CTL + 16384) + (i), __builtin_amdgcn_s_memrealtime(), __ATOMIC_RELAXED, __HIP_MEMORY_SCOPE_AGENT); } while (0)
#ifndef USE_CG_SYNC
#define USE_CG_SYNC 1
#endif
#ifndef PH_MASK
#define PH_MASK 0x3ff
#endif
#define IN(k) (((PH_MASK >> (k)) & 1) && lo <= (k) && (k) < hi)
#ifndef REP_MASK
#define REP_MASK 0
#endif
#define REPS(k) (((REP_MASK >> (k)) & 1) ? 2 : 1)
#define SEAM(k) do { if (IN(k) && IN((k) + 1)) { if ((k) == 0 && USE_CG_SYNC) cg::this_grid().sync(); else xcd_barrier(xbar, wave == 0 && lane_id() == 0); } if (bx == 0) TS_STAMP((k) + 1); } while (0)
    { volatile LAS unsigned* misc = (volatile LAS unsigned*)(L + MISC_OFF); if (threadIdx.x < 16) misc[threadIdx.x] = 0u; __syncthreads(); }
    const bool whole = (lo == 0 && hi == N_PHASES);
    if (whole && bx == 0) { unsigned* cw = (unsigned*)(ws + WS_CTL) + threadIdx.x;
#pragma unroll
        for (int i = 0; i < CTL_ZERO_BYTES / 4 / NTHREADS; ++i) __hip_atomic_store(cw + i * NTHREADS, 0u, __ATOMIC_RELAXED, __HIP_MEMORY_SCOPE_AGENT);
        asm volatile("s_waitcnt vmcnt(0)" ::: "memory"); }
    XcdBarrier xbar;
    if (!whole) xbar = xcd_barrier_post((unsigned*)(ws + WS_CTL) + CW_BAR, (volatile LAS unsigned*)(L + MISC_OFF) + 8, threadIdx.x == 0);
    bf16* const WinT = (bf16*)(ws + WS_WIN); bf16* const WupRT = (bf16*)(ws + WS_WUPR); bf16* const WupFT = (bf16*)(ws + WS_WUPF); bf16* const WoT = (bf16*)(ws + WS_WO);
    bf16* const WgT = (bf16*)(ws + WS_WGATE); bf16* const WpT = (bf16*)(ws + WS_WPLE); bf16* const WlT = (bf16*)(ws + WS_WLORA);
    bf16* const ZRW = (bf16*)(ws + WS_ZRW); bf16* const ZFX = (bf16*)(ws + WS_ZFX); bf16* const ZG = (bf16*)(ws + WS_ZG); float* const ZS = (float*)(ws + WS_ZS);
    bf16* const LA = (bf16*)(ws + WS_LA); bf16* const PB = (bf16*)(ws + WS_PB); float* const CF = (float*)(ws + WS_CF); float* const SS1 = (float*)(ws + WS_SS1); float* const SS2 = (float*)(ws + WS_SS2); bf16* const XT = (bf16*)(ws + WS_ZG + 64 * MiB)  ; float* const FLG = (float*)(ws + WS_FL);
    bf16* const T1 = ZFX + 1024  ; bf16* const MG = (bf16*)(ws + WS_MG); bf16* const X2B = MG; float* const X1 = (float*)(ws + WS_X1); bf16* const X1B = (bf16*)(ws + WS_X1B); bf16* const PLEB = (bf16*)(ob + OUT_H)  ;
    bf16* const HB = (bf16*)(ob + OUT_H); bf16* const DEC = (bf16*)(ob + OUT_DEC); bf16* const AG = (bf16*)(ob + OUT_AG); bf16* const YR = (bf16*)(ws + WS_YR);

    if (bx == 0) TS_STAMP(0);
    if (IN(0)) for (int rep_ = 0; rep_ < REPS(0); ++rep_) {
        LANE_HERE;
        const int tid = wave * 64 + lane;
        const float* w_in = args.in[I_WIN];
#define TRJOB(W_, K_, ldw_, n0_, cnt_, WT_, ldt_, ro_, ksc_) do { const int nblk_ = ((cnt_) + 63) / 64, items_ = ((K_) / 256) * nblk_; \
        for (int it = vcu; it < items_; it += G) tr_wg_item(W_, ldw_, n0_, cnt_, WT_, ldt_, ro_, ksc_, L, it, nblk_, tid); } while (0)
        TRJOB(w_in, D, N_IN, 0, 4096, WinT, D, 0, nullptr);
        TRJOB(w_in, D, N_IN, 4224, 4096, WinT, D, 4096, nullptr);
        TRJOB(w_in, D, N_IN, 8336, 4096, WinT, D, 8192, nullptr);
        TRJOB(w_in, D, N_IN, 4096, 128, WinT, D, 12288, nullptr);
        TRJOB(w_in, D, N_IN, 8320, 16, WinT, D, 12416, nullptr);
        for (int i = gw * 64 + lane; i < (NZ - 12480) * D / 8; i += NGW * 64) *(v4u*)(WinT + (size_t)12480 * D + (size_t)i * 8) = (v4u){0u, 0u, 0u, 0u};
        TRJOB(args.in[I_WUPR], C, D, 0, D, WupRT, C, 0, nullptr);
        TRJOB(args.in[I_WUPF], C, D, 0, D, WupFT, C, 0, nullptr);
        if (G != 256) {
        TRJOB(args.in[I_WOUT], D, D, 0, D, WoT, D, 0, nullptr);
        TRJOB(args.in[I_PLEGATE], D, D, 0, D, WgT, D, 0, args.in[I_PLENORMG]);
        TRJOB(args.in[I_PLEPROJ], PLE, D, 0, D, WpT, PLE, 0, nullptr); }
#undef TRJOB
        for (int i = gw * 64 + lane; i < 2048 * 32; i += NGW * 64) { const int n = i >> 5, kc = i & 31, k0 = 8 * kc; float v[8];
#pragma unroll
            for (int e = 0; e < 8; ++e) v[e] = 0.f;
            if (n < 1024 && k0 < 64) {
#pragma unroll
                for (int e = 0; e < 8; ++e) v[e] = args.in[I_WLORA][(size_t)(k0 + e) * C + n]; }
            else if (n >= 1024 && k0 >= 64 && k0 < 128) {
#pragma unroll
                for (int e = 0; e < 8; ++e) v[e] = args.in[I_ALORA][(size_t)(k0 - 64 + e) * C + (n - 1024)]; }
            *(v4u*)(WlT + (size_t)n * 256 + k0) = (v4u){pk2(v[0], v[1]), pk2(v[2], v[3]), pk2(v[4], v[5]), pk2(v[6], v[7])}; }
        { const float* x = args.in[I_X]; const float* g = args.in[I_NORMG]; f32x4 gv[8];
#pragma unroll
          for (int j = 0; j < 8; ++j) gv[j] = ((const f32x4*)g)[lane + 64 * j];
          for (int m = gw; m < M; m += NGW) { const f32x4* xr = (const f32x4*)(x + (size_t)m * D) + lane; f32x4 v[8]; float s = 0.f;
#pragma unroll
            for (int j = 0; j < 8; ++j) { v[j] = __builtin_nontemporal_load(xr + 64 * j); s += (v[j].x * v[j].x + v[j].y * v[j].y) + (v[j].z * v[j].z + v[j].w * v[j].w); }
            const float rstd = 1.f / sqrtf(wave_sum(s) * (1.f / D) + NORM_EPS);
            v2u* o8 = (v2u*)(HB + (size_t)m * D) + lane;
#pragma unroll
            for (int j = 0; j < 8; ++j) { const f32x4 y = v[j] * rstd * gv[j]; o8[64 * j] = (v2u){pk2(y.x, y.y), pk2(y.z, y.w)}; }
            if (G != 256 || !(lo == 0 && hi == N_PHASES)) {
            v2u* x8 = (v2u*)(XT + (size_t)(m >> 8) * 8 * 65536 + (size_t)(m & 255) * 256) + lane;
#pragma unroll
            for (int j = 0; j < 8; ++j) x8[(size_t)j * 16384] = (v2u){pk2(v[j].x, v[j].y), pk2(v[j].z, v[j].w)}; } } }
        { const float* p = args.in[I_P];
          for (int i = gw * 64 + lane; i < M * PLE / 8; i += NGW * 64) { const f32x4 a = __builtin_nontemporal_load((const f32x4*)p + 2 * i), b = __builtin_nontemporal_load((const f32x4*)p + 2 * i + 1);
            *(v4u*)(PB + (size_t)i * 8) = (v4u){pk2(a.x, a.y), pk2(a.z, a.w), pk2(b.x, b.y), pk2(b.z, b.w)}; } }
    }
    SEAM(0);
    if (whole) xbar = xcd_barrier_post((unsigned*)(ws + WS_CTL) + CW_BAR, (volatile LAS unsigned*)(L + MISC_OFF) + 8, wave == 0 && lane_id() == 0);
    if (IN(1)) for (int rep_ = 0; rep_ < REPS(1); ++rep_) {
        pg8::Gemm g{HB, WinT, M, NZ, D, D, D}; P1Order S; S.A.init(M, 17, G, bx, 0, 16, 32);
        const int NSCAN1 = BATCH * H; S.hasB = (bx >= NSCAN1) && (G == 256); S.B.init(M, 32, G - NSCAN1, bx >= NSCAN1 ? bx - NSCAN1 : 0, 16, 1 << 20, 0);
        pg8::EpiZ E{ZRW, (size_t)(WS_ZFX - WS_ZRW) / 2, ZS, attn_body::C2, (unsigned*)(ws + WS_CTL) + CW_NRM, FLG};
        pg8::gemm_phase<pg8::EpiZ, P1Order, true, true>(L, g, S, E, wave);
    }
    SEAM(1);
    if (IN(2)) {
        LANE_HERE;
        const float* mu = args.in[I_MU];
        {
            const float* __restrict__ zs = ZS; constexpr int NIT = 4; f32x4 a0[NIT], a1[NIT], p0[NIT], p1[NIT];
            const int i0 = gw * 64 + lane, istep = NGW * 64;
#pragma unroll
            for (int it = 0; it < NIT; ++it) { const int i = i0 + it * istep; const int m = i >> 4, c8 = i & 15; a0[it] = (f32x4){0.f, 0.f, 0.f, 0.f}; a1[it] = a0[it]; p0[it] = a0[it]; p1[it] = a0[it];
                if (i < M * 16) { const float* zc = zs + (size_t)m * 256 + 8 * c8; a0[it] = *(const f32x4*)zc; a1[it] = *(const f32x4*)(zc + 4);
                    if ((m & (T - 1)) != 0) { p0[it] = *(const f32x4*)(zc - 256); p1[it] = *(const f32x4*)(zc - 252); } } }
#pragma unroll
            for (int it = 0; it < NIT; ++it) { const int i = i0 + it * istep; const int m = i >> 4, c8 = i & 15;
                if (i < M * 16) { const f32x4 m0 = *(const f32x4*)(mu + 4096 + 8 * c8), m1 = *(const f32x4*)(mu + 4100 + 8 * c8);
                    f32x4 s0 = a0[it] + (p0[it] - a0[it]) * m0, s1 = a1[it] + (p1[it] - a1[it]) * m1;
                    if (c8 < 8) {
#pragma unroll
                        for (int e = 0; e < 4; ++e) { s0[e] = 1.f - 2.f * __builtin_amdgcn_rcpf(1.f + __builtin_amdgcn_exp2f(2.885390081777927f * s0[e])); s1[e] = 1.f - 2.f * __builtin_amdgcn_rcpf(1.f + __builtin_amdgcn_exp2f(2.885390081777927f * s1[e])); } }
                    *(v4u*)(LA + (size_t)m * 256 + 8 * c8) = (v4u){pk2(s0.x, s0.y), pk2(s0.z, s0.w), pk2(s1.x, s1.y), pk2(s1.z, s1.w)};
                    *(v4u*)(LA + (size_t)m * 256 + 128 + 8 * c8) = (v4u){0u, 0u, 0u, 0u}; } }
            for (int i = i0 + NIT * istep; i < M * 16; i += istep) {
                const int m = i >> 4, c8 = i & 15; const float* zc = zs + (size_t)m * 256 + 8 * c8; const f32x4 b0 = *(const f32x4*)zc, b1 = *(const f32x4*)(zc + 4); f32x4 q0 = {0.f, 0.f, 0.f, 0.f}, q1 = q0;
                if ((m & (T - 1)) != 0) { q0 = *(const f32x4*)(zc - 256); q1 = *(const f32x4*)(zc - 252); }
                const f32x4 m0 = *(const f32x4*)(mu + 4096 + 8 * c8), m1 = *(const f32x4*)(mu + 4100 + 8 * c8);
                f32x4 s0 = b0 + (q0 - b0) * m0, s1 = b1 + (q1 - b1) * m1;
                if (c8 < 8) {
#pragma unroll
                    for (int e = 0; e < 4; ++e) { s0[e] = 1.f - 2.f * __builtin_amdgcn_rcpf(1.f + __builtin_amdgcn_exp2f(2.885390081777927f * s0[e])); s1[e] = 1.f - 2.f * __builtin_amdgcn_rcpf(1.f + __builtin_amdgcn_exp2f(2.885390081777927f * s1[e])); } }
                *(v4u*)(LA + (size_t)m * 256 + 8 * c8) = (v4u){pk2(s0.x, s0.y), pk2(s0.z, s0.w), pk2(s1.x, s1.y), pk2(s1.z, s1.w)};
                *(v4u*)(LA + (size_t)m * 256 + 128 + 8 * c8) = (v4u){0u, 0u, 0u, 0u}; }
        }
    }
    SEAM(2);
    if (IN(3)) for (int rep_ = 0; rep_ < REPS(3); ++rep_) {
        pg8::Gemm g{LA, WlT, M, 2048, 128, 256, 256}; pg8::StaticOrder S; S.init(M, 2048, G, bx);
        pg8::EpiLora E{DEC, AG, args.in[I_W0], args.in[I_A0]};
        pg8::gemm_phase<pg8::EpiLora, pg8::StaticOrder, true, true>(L, g, S, E, wave);
    }
    SEAM(3);
    if (IN(4)) {
        unsigned* const ctl = (unsigned*)(ws + WS_CTL);
        const int NSCAN = BATCH * H;
        if (bx < NSCAN) {
            for (int rep_ = 0; rep_ < REPS(4); ++rep_) {
            scan2::Params SP{ZRW, DEC, AG, YR, args.in[I_MU], args.in[I_KK], args.in[I_KA], args.in[I_RK], args.in[I_LNG], args.in[I_LNB]};
            scan2::scan_head(L, SP, bx, wave, (PROBE_TS_A >= 20 && bx == 0) ? (unsigned long long*)(ws + WS_CTL + 16384) : nullptr); }
            if (bx == 0) TS_STAMP(16);
        } else {
            if (bx - NSCAN < 4 * BATCH) {
                const int lane = lane_id(), cq = bx - NSCAN, b = cq >> 2, qd = cq & 3, h = lane & 15, tq = lane >> 4, t0 = 1024 * qd + 128 * wave; const float bf = args.in[I_BF][h];
                const float* src = FLG + ((size_t)b * T + t0 + tq) * 16 + h; float xv[32];
#pragma unroll
                for (int j = 0; j < 32; ++j) xv[j] = src[(size_t)j * 64];
                float carry = 0.f;
#pragma unroll
                for (int j = 0; j < 32; ++j) { const float xx = xv[j] + bf; float y = fminf(xx, 0.f) - 0.6931471805599453f * __builtin_amdgcn_logf(1.f + __builtin_amdgcn_exp2f(-1.4426950408889634f * fabsf(xx)));
                    float n = __shfl_up(y, 16); if (tq >= 1) y += n; n = __shfl_up(y, 32); if (tq >= 2) y += n;
                    const float tot = __shfl(y, 48 + h); xv[j] = carry + y; carry += tot; }
                LAS float* wt = (LAS float*)(L + 1024);
                if (tq == 0) wt[wave * 16 + h] = carry;
                __syncthreads();
                float base = 0.f, all = 0.f;
#pragma unroll
                for (int w2 = 0; w2 < 8; ++w2) { const float v2 = wt[w2 * 16 + h]; all += v2; if (w2 < wave) base += v2; }
                float* qtot = (float*)(ws + WS_CTL + 24576);
                if (wave == 0 && tq == 0) __hip_atomic_store(qtot + (b * 4 + qd) * 16 + h, all, __ATOMIC_RELAXED, __HIP_MEMORY_SCOPE_AGENT);
                asm volatile("s_waitcnt vmcnt(0)" ::: "memory"); __syncthreads();
                if (wave == 0) { if (lane == 0) { __builtin_amdgcn_fence(__ATOMIC_RELEASE, "agent"); asm volatile("s_waitcnt vmcnt(0)" ::: "memory"); __hip_atomic_fetch_add(ctl + CW_CUM + b, 1u, __ATOMIC_RELAXED, __HIP_MEMORY_SCOPE_AGENT); }
                    unsigned sp = 0; while (__hip_atomic_load(ctl + CW_CUM + b, __ATOMIC_RELAXED, __HIP_MEMORY_SCOPE_AGENT) < 4u) { __builtin_amdgcn_s_sleep(2); if (++sp > (1u << 22)) break; }
                    __builtin_amdgcn_fence(__ATOMIC_ACQUIRE, "agent"); asm volatile("s_waitcnt vmcnt(0)" ::: "memory"); }
                __syncthreads();
                for (int q2 = 0; q2 < qd; ++q2) base += __hip_atomic_load(qtot + (b * 4 + q2) * 16 + h, __ATOMIC_RELAXED, __HIP_MEMORY_SCOPE_AGENT);
                float* dst = CF + ((size_t)(b * H + h)) * T + t0 + tq;
#pragma unroll
                for (int j = 0; j < 32; ++j) dst[4 * j] = (base + xv[j]) * 1.4426950408889634f;
                __syncthreads();
            }
            pg8::Gemm g{HB, WinT, M, NZ, D, D, D}; pg8::EpiZ E{ZRW, (size_t)(WS_ZFX - WS_ZRW) / 2, ZS, attn_body::C2, (unsigned*)(ws + WS_CTL) + CW_NRM, FLG};
            if (G == 256) { RestOrder S; S.B.init(M, 32, G - NSCAN, bx - NSCAN, 16, 1 << 20, 0); pg8::gemm_phase<pg8::EpiZ, RestOrder, true, true>(L, g, S, E, wave); }
            else { SubOrder S; S.init(M, 32, G - NSCAN, bx - NSCAN, 16, 1 << 20, 0); pg8::gemm_phase<pg8::EpiZ, SubOrder, true, true>(L, g, S, E, wave); }
            if (G == 256 && bx - NSCAN >= 128) {
                __syncthreads(); const int tid4 = wave * 64 + lane_id(), c4 = bx - NSCAN - 128;
                for (int it = c4; it < 544; it += 64) {
                    const bool isP = it < 32, isO = !isP && it < 288;
                    const float* W = isP ? args.in[I_PLEPROJ] : (isO ? args.in[I_WOUT] : args.in[I_PLEGATE]); bf16* WT = isP ? WpT : (isO ? WoT : WgT);
                    tr_wg_item(W, D, 0, D, WT, isP ? PLE : D, 0, (isP || isO) ? nullptr : args.in[I_PLENORMG], L, isP ? it : (isO ? it - 32 : it - 288), 32, tid4); }
            }
            asm volatile("s_waitcnt vmcnt(0)" ::: "memory"); __syncthreads();
            if (bx == 64) TS_STAMP(17);
            if (wave == 0 && lane_id() == 0) { __builtin_amdgcn_fence(__ATOMIC_RELEASE, "agent"); asm volatile("s_waitcnt vmcnt(0)" ::: "memory"); __hip_atomic_fetch_add(ctl + CW_RESTDONE, 1u, __ATOMIC_RELAXED, __HIP_MEMORY_SCOPE_AGENT); }
        }
        if (wave == 0) { unsigned sp = 0; while (__hip_atomic_load(ctl + CW_RESTDONE, __ATOMIC_RELAXED, __HIP_MEMORY_SCOPE_AGENT) < (unsigned)(G - NSCAN)) { __builtin_amdgcn_s_sleep(8); if (++sp > (1u << 22)) break; }
            __builtin_amdgcn_fence(__ATOMIC_ACQUIRE, "agent"); asm volatile("s_waitcnt vmcnt(0)" ::: "memory"); }
        __syncthreads();
        volatile LAS unsigned* slot = (volatile LAS unsigned*)(L + MISC_OFF);
        bool pend = false;
        for (;;) {
            if (wave == 0 && lane_id() == 0) slot[0] = atomicAdd(ctl + CW_QHEAD, 1u);
            asm volatile("s_waitcnt vmcnt(0)" ::: "memory"); __syncthreads();
            if (pend && wave == 0 && lane_id() == 0) { __builtin_amdgcn_fence(__ATOMIC_RELEASE, "agent"); asm volatile("s_waitcnt vmcnt(0)" ::: "memory"); __hip_atomic_fetch_add(ctl + CW_ATTNDONE, 1u, __ATOMIC_RELAXED, __HIP_MEMORY_SCOPE_AGENT); }
            const unsigned idx = slot[0];
            __syncthreads();
            if (idx >= 1024u) break;
            pend = true;
            const int qb = 15 - (int)(idx >> 6), bh = (int)(idx & 63u);
            const float bnd2 = 4.08f * sqrtf(__uint_as_float(__hip_atomic_load(ctl + CW_NRM + 2 * bh, __ATOMIC_RELAXED, __HIP_MEMORY_SCOPE_AGENT)) * __uint_as_float(__hip_atomic_load(ctl + CW_NRM + 2 * bh + 1, __ATOMIC_RELAXED, __HIP_MEMORY_SCOPE_AGENT)));
            attn_body::attn_unit<8>(bh >> 4, bh & 15, qb, (const attn_body::bf16*)ZFX, (const attn_body::bf16*)(ZFX + 1024), (const attn_body::bf16*)(ZFX + 2048), (const attn_body::bf16*)(ZFX + 3072), CF, (attn_body::bf16*)ZFX, (char*)lds, wave, bnd2);
        }
        if (bx >= NSCAN) {
            if (wave == 0) { unsigned sp = 0; while (__hip_atomic_load(ctl + CW_ATTNDONE, __ATOMIC_RELAXED, __HIP_MEMORY_SCOPE_AGENT) < 1024u) { __builtin_amdgcn_s_sleep(8); if (++sp > (1u << 22)) break; }
                __builtin_amdgcn_fence(__ATOMIC_ACQUIRE, "agent"); asm volatile("s_waitcnt vmcnt(0)" ::: "memory"); }
            __syncthreads();
            pg8::Gemm g{ZFX, WupFT, M, D, C, 4096, C}; pg8::StaticOrder S; S.init(M, D, G - NSCAN, bx - NSCAN); pg8::EpiT1 E{T1, ZG, 2048, 4096};
            pg8::gemm_phase<pg8::EpiT1, pg8::StaticOrder, true, true>(L, g, S, E, wave);
            if (G == 256) { pg8::Gemm g2{PB, WpT, M, D, PLE, PLE, PLE}; PleOrder S2; S2.c = bx - NSCAN; pg8::EpiPlainN E2{PLEB};
                pg8::gemm_phase<pg8::EpiPlainN, PleOrder, true, true>(L, g2, S2, E2, wave); }
            if (G == 256 && (lo == 0 && hi == N_PHASES)) {
                const int lane = lane_id(); const float* x = args.in[I_X];
                for (int m = (bx - NSCAN) * NWAVES + wave; m < M; m += 2 * (G - NSCAN) * NWAVES) { const int m2 = m + (G - NSCAN) * NWAVES; const bool two = m2 < M;
                    const f32x4* xr = (const f32x4*)(x + (size_t)m * D) + lane; const f32x4* xr2 = (const f32x4*)(x + (size_t)(two ? m2 : m) * D) + lane; f32x4 va[8], vb[8];
#pragma unroll
                    for (int j = 0; j < 8; ++j) { va[j] = __builtin_nontemporal_load(xr + 64 * j); vb[j] = __builtin_nontemporal_load(xr2 + 64 * j); }
                    v2u* xa = (v2u*)(XT + (size_t)(m >> 8) * 8 * 65536 + (size_t)(m & 255) * 256) + lane; v2u* xb = (v2u*)(XT + (size_t)(m2 >> 8) * 8 * 65536 + (size_t)(m2 & 255) * 256) + lane;
#pragma unroll
                    for (int j = 0; j < 8; ++j) { xa[(size_t)j * 16384] = (v2u){pk2(va[j].x, va[j].y), pk2(va[j].z, va[j].w)}; if (two) xb[(size_t)j * 16384] = (v2u){pk2(vb[j].x, vb[j].y), pk2(vb[j].z, vb[j].w)}; } }
            }
        }
    }
    if (IN(4)) { if (bx == 64) TS_STAMP(18); if (bx == 0) TS_STAMP(19); }
    SEAM(4);
    if (bx == 0) TS_STAMP(6);
    if (IN(6)) for (int rep_ = 0; rep_ < REPS(6); ++rep_) {
        pg8::Gemm g{YR, WupRT, M, D, C, C, C}; pg8::StaticOrder S; S.init(M, D, G, bx); pg8::EpiMerge E{T1, ZG, MG, 0, 4096};
        pg8::gemm_phase<pg8::EpiMerge, pg8::StaticOrder, true, true>(L, g, S, E, wave);
    }
    SEAM(6);
    if (IN(7)) for (int rep_ = 0; rep_ < REPS(7); ++rep_) {
        { pg8::Gemm g{MG, WoT, M, D, D, D, D}; PairOrder S; S.c = bx; S.pair = (G == 256); S.base.init(M, D, G, bx); pg8::EpiX1 E{XT, X1B, SS1};
          pg8::gemm_phase<pg8::EpiX1, PairOrder, true, true>(L, g, S, E, wave); }
        if (G != 256) { pg8::Gemm g{PB, WpT, M, D, PLE, PLE, PLE}; pg8::StaticOrder S; S.init(M, D, G, bx); pg8::EpiPlainN E{PLEB};
          pg8::gemm_phase<pg8::EpiPlainN, pg8::StaticOrder, true, true>(L, g, S, E, wave); }
    }
    SEAM(7);
    if (IN(8)) for (int rep_ = 0; rep_ < REPS(8); ++rep_) {
        pg8::Gemm g{X1B, WgT, M, D, D, D, D}; pg8::StaticOrder S; S.init(M, D, G, bx); pg8::EpiX2 E{X1B, PLEB, SS1, X2B, NORM_EPS};
        pg8::gemm_phase<pg8::EpiX2, pg8::StaticOrder, true, true>(L, g, S, E, wave);
    }
    SEAM(8);
    if (IN(9)) {
        LANE_HERE;
        const float* g = args.in[I_FINALG]; f32x4 gv[4][2];
#pragma unroll
        for (int j = 0; j < 4; ++j) { gv[j][0] = ((const f32x4*)g)[2 * (lane + 64 * j)]; gv[j][1] = ((const f32x4*)g)[2 * (lane + 64 * j) + 1]; }
        for (int m = gw; m < M; m += NGW) {
            const pg8::u32x4* xr = (const pg8::u32x4*)(X2B + (size_t)m * D) + lane; pg8::u32x4 xv[4];
#pragma unroll
            for (int j = 0; j < 4; ++j) xv[j] = __builtin_nontemporal_load(xr + 64 * j);
            f32x4 v[4][2]; float s = 0.f;
#pragma unroll
            for (int j = 0; j < 4; ++j) { pg8::unpack8(xv[j], v[j][0], v[j][1]);
                s += ((v[j][0].x * v[j][0].x + v[j][0].y * v[j][0].y) + (v[j][0].z * v[j][0].z + v[j][0].w * v[j][0].w)) + ((v[j][1].x * v[j][1].x + v[j][1].y * v[j][1].y) + (v[j][1].z * v[j][1].z + v[j][1].w * v[j][1].w)); }
            const float rstd = 1.f / sqrtf(wave_sum(s) * (1.f / D) + NORM_EPS);
            f32x4* orow = (f32x4*)(args.out + (size_t)m * D) + 2 * lane;
#pragma unroll
            for (int j = 0; j < 4; ++j) { orow[128 * j] = v[j][0] * rstd * gv[j][0]; orow[128 * j + 1] = v[j][1] * rstd * gv[j][1]; } }
        if (PROBE_TS_A >= 0 && bx == 0 && wave == 0 && lane == 0) { const unsigned long long* ts = (const unsigned long long*)(ws + WS_CTL + 16384);
            const unsigned long long ta = __hip_atomic_load(ts + (PROBE_TS_A < 0 ? 0 : PROBE_TS_A), __ATOMIC_RELAXED, __HIP_MEMORY_SCOPE_AGENT), tb = (PROBE_TS_B == 100) ? __builtin_amdgcn_s_memrealtime() : __hip_atomic_load(ts + ((PROBE_TS_B < 0 || PROBE_TS_B == 100) ? 0 : PROBE_TS_B), __ATOMIC_RELAXED, __HIP_MEMORY_SCOPE_AGENT);
            asm volatile("s_waitcnt vmcnt(0)" ::: "memory"); const float dus = (float)(long long)(tb - ta) * 0.01f; args.out[0] += floorf(8.f * log2f(fmaxf(dus, 1.f)) + 0.5f + PROBE_TS_OFF); }
    }
#undef IN
#undef SEAM
}

extern "C" void kernel_launch(void* const* d_in, const int* in_sizes, int n_in, void* d_out, int out_size, void* d_ws, size_t ws_size, hipStream_t stream) {
    static int grid = 0;
    if (grid == 0) {
        if (n_in != 22 || out_size != M * D || ws_size < WS_END) { fprintf(stderr, "kernel_launch: unexpected shapes (n_in %d, out %d, ws %zu)\n", n_in, out_size, ws_size); grid = -1; return; }
        int dev = 0, cus = 0, per_cu = 0;
        hipGetDevice(&dev); hipDeviceGetAttribute(&cus, hipDeviceAttributeMultiprocessorCount, dev);
        if (hipFuncSetAttribute((const void*)mk_fwd, hipFuncAttributeMaxDynamicSharedMemorySize, LDS_BYTES) != hipSuccess) { fprintf(stderr, "kernel_launch: hipFuncSetAttribute failed\n"); grid = -1; return; }
        if (hipOccupancyMaxActiveBlocksPerMultiprocessor(&per_cu, (const void*)mk_fwd, NTHREADS, LDS_BYTES) != hipSuccess || per_cu < 1) { fprintf(stderr, "kernel_launch: occupancy query says %d\n", per_cu); per_cu = 1; }
        (void)hipGetLastError();
        grid = cus;
        if (grid % 8 != 0 || grid > 256) grid = (grid > 256) ? 256 : (grid / 8) * 8;
    }
    if (grid <= 0) return;
#if MK_PER_PHASE_LAUNCHES
    hipMemsetAsync((char*)d_ws + WS_CTL, 0, CTL_ZERO_BYTES, stream);
#endif
    Args a{};
    for (int i = 0; i < 22; ++i) a.in[i] = (const float*)d_in[i];
    a.out = (float*)d_out; a.ws = (unsigned char*)d_ws;
#if MK_PER_PHASE_LAUNCHES
    for (int p = 0; p < N_PHASES; ++p) { a.ph_lo = p; a.ph_hi = p + 1; hipLaunchKernelGGL(mk_fwd, dim3(grid), dim3(NTHREADS), LDS_BYTES, stream, a); }
#else
    a.ph_lo = 0; a.ph_hi = N_PHASES;
    void* kargs[] = {&a};
    hipError_t e = hipLaunchCooperativeKernel((const void*)mk_fwd, dim3(grid), dim3(NTHREADS), kargs, LDS_BYTES, stream);
    if (e != hipSuccess) fprintf(stderr, "kernel_launch: cooperative launch failed: %s (grid %d)\n", hipGetErrorString(e), grid);
#endif
}
```

```cpp
#include <hip/hip_runtime.h>
#include <cstdio>
#include <cstdint>
__device__ __forceinline__ int lane_id() { int l; asm volatile("v_mbcnt_lo_u32_b32 %0, -1, 0\n\tv_mbcnt_hi_u32_b32 %0, -1, %0" : "=v"(l)); return l; }
namespace pg8 {
#define PG8_LAS __attribute__((address_space(3)))
typedef unsigned short bf16_t;
typedef short bf16x8 __attribute__((ext_vector_type(8)));
typedef float f32x4 __attribute__((ext_vector_type(4)));
typedef unsigned u32x4 __attribute__((ext_vector_type(4)));
constexpr int BM = 256, BK = 64, HALF = 128, HTB = HALF * BK * 2  , STAGE_BYTES = 8 * HTB, NXCD = 8, WGM = 3;

__host__ __device__ __forceinline__ int lds_byte(int r, int c) { const int st = (r >> 4) * 2 + (c >> 5), rr = r & 15, cc = c & 31, ob = rr * 64 + cc * 2; return st * 1024 + (ob ^ (((ob >> 9) & 1) << 5)); }
__host__ __device__ __forceinline__ void stage_rc(int b, int& R, int& C) { const int st = b / 1024, sb = b % 1024, swz = sb ^ (((sb >> 9) & 1) << 5); R = (st >> 1) * 16 + swz / 64; C = (st & 1) * 32 + (swz % 64) / 2; }
__host__ __device__ __forceinline__ int perm32(int rho) { const int n = rho >> 4, i = rho & 15; return 8 * (i >> 2) + 4 * n + (i & 3); }

struct Unit { int pm, pn; };
struct Gemm { const bf16_t* A; const bf16_t* Bt; int M, N, K, lda, ldb; };

struct StaticOrder {
    int nM, nN, nwg, G, c;
    __host__ __device__ void init(int M, int N, int G_, int c_) { nM = M / BM; nN = N / BM; nwg = nM * nN; G = G_; c = c_; }
    __host__ __device__ bool next(int i, Unit& u) const {
        const long L = (long)i * G + c; if (L >= nwg) return false;
        int wgid = (int)L; { const int q = nwg / NXCD, r = nwg % NXCD, xcd = wgid % NXCD, off = wgid / NXCD; wgid = (xcd < r ? xcd * (q + 1) : r * (q + 1) + (xcd - r) * q) + off; }
        const int nig = WGM * nN, gid = wgid / nig, fm = gid * WGM, gsz = (nM - fm) < WGM ? (nM - fm) : WGM;
        u.pm = fm + ((wgid % nig) % gsz); u.pn = (wgid % nig) / gsz; return true;
    }
    __device__ __forceinline__ void a_ready(const Unit&) const {}
    __device__ __forceinline__ void done(const Unit&) const {}
};

__device__ __forceinline__ unsigned cvt_pk_bf16(float lo, float hi) { unsigned r; asm volatile("v_cvt_pk_bf16_f32 %0, %1, %2" : "=v"(r) : "v"(lo), "v"(hi)); return r; }
__device__ __forceinline__ float sigm(float x) { return __builtin_amdgcn_rcpf(1.f + __builtin_amdgcn_exp2f(-1.4426950408889634f * x)); }
__device__ __forceinline__ float bf_lo(unsigned u) { return __uint_as_float(u << 16); }
__device__ __forceinline__ float bf_hi(unsigned u) { return __uint_as_float(u & 0xffff0000u); }
__device__ __forceinline__ u32x4 pack8(const f32x4& v0, const f32x4& v1) { u32x4 w; w.x = cvt_pk_bf16(v0[0], v0[1]); w.y = cvt_pk_bf16(v0[2], v0[3]); w.z = cvt_pk_bf16(v1[0], v1[1]); w.w = cvt_pk_bf16(v1[2], v1[3]); return w; }
__device__ __forceinline__ void unpack8(const u32x4& w, f32x4& v0, f32x4& v1) { v0 = (f32x4){bf_lo(w.x), bf_hi(w.x), bf_lo(w.y), bf_hi(w.y)}; v1 = (f32x4){bf_lo(w.z), bf_hi(w.z), bf_lo(w.w), bf_hi(w.w)}; }
__device__ __forceinline__ size_t nat_base(int tile, int wr, int wc, int fr, int fq) {
    (void)fr; (void)fq; return (size_t)tile * 65536 + (size_t)(((wr * 4 + wc) * 64 + lane_id()) * 8); }
#define NAT_STEP(ai, m, bj) (((((ai) * 4 + (m)) * 2 + (bj)) * 4096))
__device__ __forceinline__ size_t t1_off(int tile, int step, int wr, int wc) { const int ch = (tile * 16 + step) * 8 + wr * 4 + wc; return (size_t)(ch >> 2) * 4096 + (size_t)((ch & 3) * 512) + (size_t)(lane_id() * 8); }
typedef unsigned u32x2_t __attribute__((ext_vector_type(2)));
__device__ __forceinline__ size_t nat_base8(int tile, int wr, int wc) { return (size_t)tile * 65536 + (size_t)(((wr * 4 + wc) * 64 + lane_id()) * 8); }
#define NAT8_STEP(ai, m, bj) (((((ai) * 4 + (m)) * 2 + (bj)) * 4096))
__device__ __forceinline__ unsigned q8(float s) { return (unsigned)(s * 255.f + 0.5f); }
__device__ __forceinline__ u32x2_t pack8u(const f32x4& v0, const f32x4& v1) { u32x2_t w; w.x = q8(v0[0]) | (q8(v0[1]) << 8) | (q8(v0[2]) << 16) | (q8(v0[3]) << 24); w.y = q8(v1[0]) | (q8(v1[1]) << 8) | (q8(v1[2]) << 16) | (q8(v1[3]) << 24); return w; }
__device__ __forceinline__ void unpack8u(const u32x2_t& w, f32x4& g0, f32x4& g1) { const float k = 1.f / 255.f;
    g0 = (f32x4){(float)(w.x & 255u) * k, (float)((w.x >> 8) & 255u) * k, (float)((w.x >> 16) & 255u) * k, (float)(w.x >> 24) * k}; g1 = (f32x4){(float)(w.y & 255u) * k, (float)((w.y >> 8) & 255u) * k, (float)((w.y >> 16) & 255u) * k, (float)(w.y >> 24) * k}; }
#define PG8_EPI_LOOP _Pragma("unroll") for (int ai = 0; ai < 2; ++ai) _Pragma("unroll") for (int m = 0; m < 4; ++m)

struct EpiZ {
    static constexpr bool PERM = true, AFTER_DRAIN = false;
    bf16_t* Z0; size_t seg_stride; float* ZS; float qscale; unsigned* NRM; float* FL;
    __device__ __forceinline__ void operator()(const f32x4 (&acc)[2][2][4][2], const Unit& u, int wr, int wc, int fr, int fq) const {
        const int seg = u.pn >> 4, ct = u.pn & 15, row0 = u.pm * BM + wr * 64 + fr;
        if (seg == 3) {
            const int col0 = wc * 32 + 8 * fq;
            PG8_EPI_LOOP { float* rowp = ZS + (size_t)(row0 + ai * HALF + m * 16) * 256 + col0;
#pragma unroll
                for (int bj = 0; bj < 2; ++bj) { *(f32x4*)(rowp + bj * HALF) = acc[ai][bj][m][0]; *(f32x4*)(rowp + bj * HALF + 4) = acc[ai][bj][m][1]; }
                if (wc == 0 && fq < 2) { float* fp = FL + (size_t)(row0 + ai * HALF + m * 16) * 16 + 8 * fq; *(f32x4*)fp = acc[ai][1][m][0]; *(f32x4*)(fp + 4) = acc[ai][1][m][1]; } }
        } else {
            bf16_t* base = Z0 + (size_t)seg * seg_stride;
            const int col0 = ct * 256 + wc * 32 + 8 * fq;
            const float sc = (seg == 1 && ct < 4) ? qscale : 1.f;
            const bool sg = (seg == 2);
            const bool nrm = (seg == 1 && ct < 8); float mx0 = 0.f, mx1 = 0.f;
            unsigned char* const natp8 = (unsigned char*)base + nat_base8(u.pm * 16 + ct, wr, wc);
            PG8_EPI_LOOP { bf16_t* rowp = base + (size_t)(row0 + ai * HALF + m * 16) * 4096 + col0;
#pragma unroll
                for (int bj = 0; bj < 2; ++bj) { f32x4 v0 = acc[ai][bj][m][0] * sc, v1 = acc[ai][bj][m][1] * sc;
                    if (sg) {
#pragma unroll
                        for (int e = 0; e < 4; ++e) { v0[e] = sigm(v0[e]); v1[e] = sigm(v1[e]); } }
                    if (sg) *(u32x2_t*)(natp8 + NAT8_STEP(ai, m, bj)) = pack8u(v0, v1);
                    else *(u32x4*)(rowp + bj * HALF) = pack8(v0, v1);
                    if (nrm) { float s = (v0[0] * v0[0] + v0[1] * v0[1]) + (v0[2] * v0[2] + v0[3] * v0[3]) + (v1[0] * v1[0] + v1[1] * v1[1]) + (v1[2] * v1[2] + v1[3] * v1[3]);
                        s += __shfl_xor(s, 16); s += __shfl_xor(s, 32); if (bj == 0) mx0 = fmaxf(mx0, s); else mx1 = fmaxf(mx1, s); } } }
            if (nrm) {
#pragma unroll
                for (int o = 1; o < 16; o <<= 1) { mx0 = fmaxf(mx0, __shfl_xor(mx0, o)); mx1 = fmaxf(mx1, __shfl_xor(mx1, o)); }
                if (fr == 0 && fq == 0) { const int bb_ = u.pm >> 4, hd = (ct & 3) * 4 + (wc >> 1), kq_ = ct >> 2;
                    atomicMax(NRM + ((bb_ * 16 + hd) * 2 + kq_), __float_as_uint(mx0)); atomicMax(NRM + ((bb_ * 16 + hd + 2) * 2 + kq_), __float_as_uint(mx1)); } }
        }
    }
};
struct EpiZSAdd {
    static constexpr bool PERM = true, AFTER_DRAIN = false;
    float* ZS;
    __device__ __forceinline__ void operator()(const f32x4 (&acc)[2][2][4][2], const Unit& u, int wr, int wc, int fr, int fq) const {
        const int row0 = u.pm * BM + wr * 64 + fr, col0 = wc * 32 + 8 * fq;
        PG8_EPI_LOOP { float* rowp = ZS + (size_t)(row0 + ai * HALF + m * 16) * 256 + col0;
#pragma unroll
            for (int bj = 0; bj < 2; ++bj)
#pragma unroll
                for (int n = 0; n < 2; ++n)
#pragma unroll
                    for (int e = 0; e < 4; ++e) { const int c = col0 + bj * HALF + 4 * n + e; if (c < 160) __hip_atomic_fetch_add(rowp + bj * HALF + 4 * n + e, acc[ai][bj][m][n][e], __ATOMIC_RELAXED, __HIP_MEMORY_SCOPE_AGENT); } }
    }
};
struct EpiLora {
    static constexpr bool PERM = true, AFTER_DRAIN = false;
    bf16_t* DEC; bf16_t* AG; const float* w0; const float* a0;
    __device__ __forceinline__ void operator()(const f32x4 (&acc)[2][2][4][2], const Unit& u, int wr, int wc, int fr, int fq) const {
        const int row0 = u.pm * BM + wr * 64 + fr; const bool isw = u.pn < 4;
        const int col0 = (u.pn & 3) * 256 + wc * 32 + 8 * fq; const float* bias = isw ? w0 : a0;
        f32x4 bv[2][2];
#pragma unroll
        for (int bj = 0; bj < 2; ++bj) { bv[bj][0] = *(const f32x4*)(bias + col0 + bj * HALF); bv[bj][1] = *(const f32x4*)(bias + col0 + bj * HALF + 4); }
        PG8_EPI_LOOP { const size_t ro = (size_t)(row0 + ai * HALF + m * 16) * 1024 + col0;
#pragma unroll
            for (int bj = 0; bj < 2; ++bj) { f32x4 v0 = acc[ai][bj][m][0] + bv[bj][0], v1 = acc[ai][bj][m][1] + bv[bj][1];
#pragma unroll
                for (int e = 0; e < 4; ++e) { v0[e] = sigm(v0[e]); v1[e] = sigm(v1[e]); }
                if (isw) {
#pragma unroll
                    for (int e = 0; e < 4; ++e) { v0[e] = __builtin_amdgcn_exp2f(-0.8750612634f * v0[e]); v1[e] = __builtin_amdgcn_exp2f(-0.8750612634f * v1[e]); }
                    typedef _Float16 h8 __attribute__((ext_vector_type(8))); h8 hv;
#pragma unroll
                    for (int e = 0; e < 4; ++e) { hv[e] = (_Float16)(1.f - v0[e]); hv[4 + e] = (_Float16)(1.f - v1[e]); }
                    *(h8*)(DEC + ro + bj * HALF) = hv;
                } else *(u32x4*)(AG + ro + bj * HALF) = pack8(v0, v1); } }
    }
};
struct EpiPlain {
    static constexpr bool PERM = true, AFTER_DRAIN = false;
    bf16_t* O; int ldc;
    __device__ __forceinline__ void operator()(const f32x4 (&acc)[2][2][4][2], const Unit& u, int wr, int wc, int fr, int fq) const {
        const int row0 = u.pm * BM + wr * 64 + fr, col0 = u.pn * BM + wc * 32 + 8 * fq;
        PG8_EPI_LOOP { bf16_t* rowp = O + (size_t)(row0 + ai * HALF + m * 16) * ldc + col0;
#pragma unroll
            for (int bj = 0; bj < 2; ++bj) *(u32x4*)(rowp + bj * HALF) = pack8(acc[ai][bj][m][0], acc[ai][bj][m][1]); }
    }
};
struct EpiPlainN {
    static constexpr bool PERM = true, AFTER_DRAIN = false;
    bf16_t* O;
    __device__ __forceinline__ void operator()(const f32x4 (&acc)[2][2][4][2], const Unit& u, int wr, int wc, int fr, int fq) const {
        bf16_t* const op = O + nat_base(u.pm * 8 + u.pn, wr, wc, fr, fq);
        PG8_EPI_LOOP {
#pragma unroll
            for (int bj = 0; bj < 2; ++bj) *(u32x4*)(op + NAT_STEP(ai, m, bj)) = pack8(acc[ai][bj][m][0], acc[ai][bj][m][1]); }
    }
};
struct EpiT1 {
    static constexpr bool PERM = true, AFTER_DRAIN = false;
    bf16_t* T1; const bf16_t* ZG; int goff; int ldt;
    __device__ __forceinline__ void operator()(const f32x4 (&acc)[2][2][4][2], const Unit& u, int wr, int wc, int fr, int fq) const {
        const int row0 = u.pm * BM + wr * 64 + fr, col0 = u.pn * BM + wc * 32 + 8 * fq;
        u32x2_t gz[2][4][2];
        const unsigned char* const zgp = (const unsigned char*)ZG + nat_base8(u.pm * 16 + (goff >> 8) + u.pn, wr, wc);
#pragma unroll
        for (int ai = 0; ai < 2; ++ai)
#pragma unroll
            for (int m = 0; m < 4; ++m)
#pragma unroll
                for (int bj = 0; bj < 2; ++bj) gz[ai][m][bj] = __builtin_nontemporal_load((const u32x2_t*)(zgp + NAT8_STEP(ai, m, bj)));
        __builtin_amdgcn_sched_barrier(0);
#pragma unroll
        for (int ai = 0; ai < 2; ++ai)
#pragma unroll
            for (int m = 0; m < 4; ++m) { const size_t r = (size_t)(row0 + ai * HALF + m * 16);
#pragma unroll
                for (int bj = 0; bj < 2; ++bj) { f32x4 g0, g1; unpack8u(gz[ai][m][bj], g0, g1);
                    *(u32x4*)(T1 + t1_off(u.pm * 8 + u.pn, (ai * 4 + m) * 2 + bj, wr, wc)) = pack8(acc[ai][bj][m][0] * g0, acc[ai][bj][m][1] * g1); } }
        __builtin_amdgcn_sched_barrier(0);
    }
};
struct EpiMerge {
    static constexpr bool PERM = true, AFTER_DRAIN = false;
    const bf16_t* T1; const bf16_t* ZG; bf16_t* MG; int goff; int ldt;
    __device__ __forceinline__ void operator()(const f32x4 (&acc)[2][2][4][2], const Unit& u, int wr, int wc, int fr, int fq) const {
        const int row0 = u.pm * BM + wr * 64 + fr, col0 = u.pn * BM + wc * 32 + 8 * fq;
        u32x2_t gz[4][2][2]; u32x4 tz[4][2][2];
        const unsigned char* const zgp = (const unsigned char*)ZG + nat_base8(u.pm * 16 + (goff >> 8) + u.pn, wr, wc);
#define EM_LOAD(q) do { _Pragma("unroll") for (int mm = 0; mm < 2; ++mm) _Pragma("unroll") for (int bj = 0; bj < 2; ++bj) { const size_t r = (size_t)(row0 + ((q) >> 1) * HALF + (2 * ((q) & 1) + mm) * 16); \
            gz[q][mm][bj] = __builtin_nontemporal_load((const u32x2_t*)(zgp + NAT8_STEP((q) >> 1, 2 * ((q) & 1) + mm, bj))); tz[q][mm][bj] = __builtin_nontemporal_load((const u32x4*)(T1 + t1_off(u.pm * 8 + u.pn, ((((q) >> 1) * 4 + 2 * ((q) & 1) + mm) * 2 + bj), wr, wc))); } } while (0)
#define EM_DO(q) do { _Pragma("unroll") for (int mm = 0; mm < 2; ++mm) { const int m = 2 * ((q) & 1) + mm; const size_t r = (size_t)(row0 + ((q) >> 1) * HALF + m * 16); \
            _Pragma("unroll") for (int bj = 0; bj < 2; ++bj) { f32x4 g0, g1, t0, t1; unpack8u(gz[q][mm][bj], g0, g1); unpack8(tz[q][mm][bj], t0, t1); \
                *(u32x4*)(MG + r * 2048 + col0 + bj * HALF) = pack8(t0 + acc[(q) >> 1][bj][m][0] * g0, t1 + acc[(q) >> 1][bj][m][1] * g1); } } } while (0)
        EM_LOAD(0); EM_LOAD(1); __builtin_amdgcn_sched_barrier(0);
        EM_DO(0); __builtin_amdgcn_sched_barrier(0); EM_LOAD(2); __builtin_amdgcn_sched_barrier(0);
        EM_DO(1); __builtin_amdgcn_sched_barrier(0); EM_LOAD(3); __builtin_amdgcn_sched_barrier(0);
        EM_DO(2); __builtin_amdgcn_sched_barrier(0); EM_DO(3); __builtin_amdgcn_sched_barrier(0);
#undef EM_LOAD
#undef EM_DO
    }
};
struct EpiX1 {
    static constexpr bool PERM = true, AFTER_DRAIN = false;
    const bf16_t* XT; bf16_t* X1B; float* SS;
    __device__ __forceinline__ void operator()(const f32x4 (&acc)[2][2][4][2], const Unit& u, int wr, int wc, int fr, int fq) const {
        const int row0 = u.pm * BM + wr * 64 + fr, col0 = u.pn * BM + wc * 32 + 8 * fq;
        u32x4 xv[4][2][2]; const bf16_t* const xtp = XT + (size_t)(u.pm * 8 + u.pn) * 65536 + (size_t)((wr * 64 + fr) * 256 + wc * 32 + 8 * fq);
#define EX_LOAD(q) do { _Pragma("unroll") for (int mm = 0; mm < 2; ++mm) _Pragma("unroll") for (int bj = 0; bj < 2; ++bj) \
            xv[q][mm][bj] = __builtin_nontemporal_load((const u32x4*)(xtp + (((q) >> 1) * HALF + (2 * ((q) & 1) + mm) * 16) * 256 + bj * HALF)); } while (0)
#define EX_DO(q) do { _Pragma("unroll") for (int mm = 0; mm < 2; ++mm) { const int m = 2 * ((q) & 1) + mm; const size_t r = (size_t)(row0 + ((q) >> 1) * HALF + m * 16); float ss = 0.f; \
            _Pragma("unroll") for (int bj = 0; bj < 2; ++bj) { const size_t o = r * 2048 + col0 + bj * HALF; \
                f32x4 x0_, x1_; unpack8(xv[q][mm][bj], x0_, x1_); const f32x4 v0 = acc[(q) >> 1][bj][m][0] + x0_, v1 = acc[(q) >> 1][bj][m][1] + x1_; \
                *(u32x4*)(X1B + o) = pack8(v0, v1); \
                ss += (v0[0] * v0[0] + v0[1] * v0[1]) + (v0[2] * v0[2] + v0[3] * v0[3]) + (v1[0] * v1[0] + v1[1] * v1[1]) + (v1[2] * v1[2] + v1[3] * v1[3]); } \
            ss += __shfl_xor(ss, 16); ss += __shfl_xor(ss, 32); \
            if (fq == 0) SS[r * 32 + u.pn * 4 + wc] = ss; } } while (0)
        EX_LOAD(0); EX_LOAD(1); __builtin_amdgcn_sched_barrier(0);
        EX_DO(0); __builtin_amdgcn_sched_barrier(0); EX_LOAD(2); __builtin_amdgcn_sched_barrier(0);
        EX_DO(1); __builtin_amdgcn_sched_barrier(0); EX_LOAD(3); __builtin_amdgcn_sched_barrier(0);
        EX_DO(2); __builtin_amdgcn_sched_barrier(0); EX_DO(3); __builtin_amdgcn_sched_barrier(0);
#undef EX_LOAD
#undef EX_DO
    }
};
struct EpiX2 {
    static constexpr bool PERM = true, AFTER_DRAIN = false;
    const bf16_t* X1B; const bf16_t* PLE; const float* SS1; bf16_t* X2B; float eps;
    __device__ __forceinline__ void operator()(const f32x4 (&acc)[2][2][4][2], const Unit& u, int wr, int wc, int fr, int fq) const {
        const int row0 = u.pm * BM + wr * 64 + fr, col0 = u.pn * BM + wc * 32 + 8 * fq;
        const bf16_t* const plp = PLE + nat_base(u.pm * 8 + u.pn, wr, wc, fr, fq);
#pragma unroll
        for (int ai = 0; ai < 2; ++ai)
#pragma unroll
            for (int mh = 0; mh < 2; ++mh) {
                u32x4 xh[2][2]; f32x4 sp[2][2]; u32x4 pz[2][2];
#pragma unroll
                for (int mm = 0; mm < 2; ++mm) { const size_t r = (size_t)(row0 + ai * HALF + (2 * mh + mm) * 16);
                    sp[mm][0] = *(const f32x4*)(SS1 + r * 32 + fq * 8); sp[mm][1] = *(const f32x4*)(SS1 + r * 32 + fq * 8 + 4);
#pragma unroll
                    for (int bj = 0; bj < 2; ++bj) { const size_t o = r * 2048 + col0 + bj * HALF; xh[mm][bj] = *(const u32x4*)(X1B + o); pz[mm][bj] = __builtin_nontemporal_load((const u32x4*)(plp + NAT_STEP(ai, 2 * mh + mm, bj))); } }
                __builtin_amdgcn_sched_barrier(0);
#pragma unroll
                for (int mm = 0; mm < 2; ++mm) { const int m = 2 * mh + mm; const size_t r = (size_t)(row0 + ai * HALF + m * 16);
                    const f32x4 p0 = sp[mm][0], p1 = sp[mm][1];
                    float s1 = (p0[0] + p0[1]) + (p0[2] + p0[3]) + (p1[0] + p1[1]) + (p1[2] + p1[3]); s1 += __shfl_xor(s1, 16); s1 += __shfl_xor(s1, 32);
                    const float nrs = -1.4426950408889634f * __builtin_amdgcn_rsqf(s1 * (1.f / 2048.f) + eps);
#pragma unroll
                    for (int bj = 0; bj < 2; ++bj) { const size_t o = r * 2048 + col0 + bj * HALF; f32x4 e0, e1; unpack8(pz[mm][bj], e0, e1);
                        f32x4 v0, v1; unpack8(xh[mm][bj], v0, v1);
#pragma unroll
                        for (int e_ = 0; e_ < 4; ++e_) { v0[e_] += e0[e_] * __builtin_amdgcn_rcpf(1.f + __builtin_amdgcn_exp2f(acc[ai][bj][m][0][e_] * nrs)); v1[e_] += e1[e_] * __builtin_amdgcn_rcpf(1.f + __builtin_amdgcn_exp2f(acc[ai][bj][m][1][e_] * nrs)); }
                        *(u32x4*)(X2B + o) = pack8(v0, v1); } }
                __builtin_amdgcn_sched_barrier(0);
            }
    }
};
template <class Epi, class Sched, bool ALIGN_EPI = false, bool SP2 = false>
__device__ __forceinline__ void gemm_phase(PG8_LAS unsigned char* lds, const Gemm g, const Sched& S, const Epi& E, const int wid  ) {
    const int lane = lane_id(), tid = wid * 64 + lane, wr = wid >> 2, wc = wid & 3, fr = lane & 15, fq = lane >> 4;
    const int K = g.K, nt = K / BK;
    unsigned voffA[2], voffB[2];
#pragma unroll
    for (int i = 0; i < 2; ++i) { int R, C; stage_rc(tid * 16 + i * 8192, R, C); const int Rb = Epi::PERM ? ((R & ~31) + perm32(R & 31)) : R;
        voffA[i] = (unsigned)(R * g.lda + C) * 2u; voffB[i] = (unsigned)(Rb * g.ldb + C) * 2u; }
    const size_t kstep = (size_t)(BK * 2);
    const size_t hstepA = (size_t)HALF * g.lda * 2, hstepB = (size_t)HALF * g.ldb * 2;
    const size_t tstepA = 2 * hstepA, tstepB = 2 * hstepB;
    const unsigned ldsw = (unsigned)wid * 1024u;
    const int aoff = lds_byte(wr * 64 + fr, fq * 8), boff = lds_byte(wc * 32 + fr, fq * 8);
#define PG8_SA(b, h) (((b) * 2 + (h)) * HTB)
#define PG8_SB(b, h) ((4 + (b) * 2 + (h)) * HTB)
#define PG8_STAGE(bufoff, gbase, voff) do { _Pragma("unroll") for (int _i = 0; _i < 2; ++_i) \
        __builtin_amdgcn_global_load_lds((const unsigned*)((const char*)(gbase) + (voff)[_i]), (PG8_LAS unsigned*)(lds + (bufoff) + ldsw + _i * 8192), 16, 0, 0); } while (0)
#define PG8_LDA(dst, b, h) do { _Pragma("unroll") for (int m = 0; m < 4; ++m) _Pragma("unroll") for (int k = 0; k < 2; ++k) dst[m][k] = *(const PG8_LAS bf16x8*)(lds + PG8_SA(b, h) + aoff + m * 2048 + k * 1024); } while (0)
#define PG8_LDB(dst, b, h) do { _Pragma("unroll") for (int n = 0; n < 2; ++n) _Pragma("unroll") for (int k = 0; k < 2; ++k) dst[n][k] = *(const PG8_LAS bf16x8*)(lds + PG8_SB(b, h) + boff + n * 2048 + k * 1024); } while (0)
#define PG8_MMA(ai, bj, At, Bt) do { __builtin_amdgcn_s_setprio(1); _Pragma("unroll") for (int m = 0; m < 4; ++m) _Pragma("unroll") for (int n = 0; n < 2; ++n) _Pragma("unroll") for (int k = 0; k < 2; ++k) \
        acc[ai][bj][m][n] = __builtin_amdgcn_mfma_f32_16x16x32_bf16(Bt[n][k], At[m][k], acc[ai][bj][m][n], 0, 0, 0); __builtin_amdgcn_s_setprio(0); } while (0)
#define PG8_WAIT_V(n) asm volatile("s_waitcnt vmcnt(" #n ")" ::: "memory")
#define PG8_WAIT_L(n) asm volatile("s_waitcnt lgkmcnt(" #n ")" ::: "memory")
#define PG8_BAR __builtin_amdgcn_s_barrier()
#define PG8_SCHED __builtin_amdgcn_sched_barrier(0)
    Unit cur, nxt; int ui = 0;
    if (!S.next(0, cur)) return;
    f32x4 acc[2][2][4][2];
#pragma unroll
    for (int a = 0; a < 2; ++a)
#pragma unroll
        for (int b = 0; b < 2; ++b)
#pragma unroll
            for (int m = 0; m < 4; ++m)
#pragma unroll
                for (int n = 0; n < 2; ++n) acc[a][b][m][n] = (f32x4){0.f, 0.f, 0.f, 0.f};
    bf16x8 At[4][2], B0[2][2], B1[2][2];
    const char* cA = (const char*)g.A + (size_t)cur.pm * tstepA; const char* cB = (const char*)g.Bt + (size_t)cur.pn * tstepB;
    S.a_ready(cur);
    if constexpr (SP2) {
        PG8_STAGE(PG8_SB(0, 0), cB, voffB); PG8_STAGE(PG8_SB(0, 1), cB + hstepB, voffB); PG8_STAGE(PG8_SA(0, 0), cA, voffA); PG8_STAGE(PG8_SA(0, 1), cA + hstepA, voffA);
        if (wr == 1) PG8_BAR;
        PG8_WAIT_V(2); PG8_BAR;
        PG8_STAGE(PG8_SB(1, 0), cB + kstep, voffB); PG8_STAGE(PG8_SA(1, 0), cA + kstep, voffA); PG8_STAGE(PG8_SB(1, 1), cB + hstepB + kstep, voffB);
        PG8_WAIT_V(6); PG8_BAR;
    } else {
        PG8_STAGE(PG8_SB(0, 0), cB, voffB); PG8_STAGE(PG8_SA(0, 0), cA, voffA); PG8_STAGE(PG8_SB(0, 1), cB + hstepB, voffB); PG8_STAGE(PG8_SA(0, 1), cA + hstepA, voffA);
        if (wr == 1) PG8_BAR;
        PG8_WAIT_V(4); PG8_BAR;
        PG8_STAGE(PG8_SB(1, 0), cB + kstep, voffB); PG8_STAGE(PG8_SA(1, 0), cA + kstep, voffA); PG8_STAGE(PG8_SB(1, 1), cB + hstepB + kstep, voffB);
        PG8_WAIT_V(6); PG8_BAR;
    }
    for (;;) {
        const bool has_next = S.next(ui + 1, nxt);
        const char* nA = has_next ? (const char*)g.A + (size_t)nxt.pm * tstepA : cA; const char* nB = has_next ? (const char*)g.Bt + (size_t)nxt.pn * tstepB : cB;
        for (int t = 0; t < nt; t += 2) {
            const bool last = (t == nt - 2);
            const char* a1 = cA + (size_t)(t + 1) * kstep;
            const char* a2 = last ? nA : cA + (size_t)(t + 2) * kstep; const char* b2 = last ? nB : cB + (size_t)(t + 2) * kstep;
            const char* a3 = a2 + kstep; const char* b3 = b2 + kstep;
            if (last && has_next) S.a_ready(nxt);
            if constexpr (SP2) {
            PG8_LDB(B0, 0, 0); PG8_LDB(B1, 0, 1); PG8_SCHED; PG8_LDA(At, 0, 0); PG8_STAGE(PG8_SA(1, 1), a1 + hstepA, voffA);
            PG8_WAIT_V(8); PG8_WAIT_L(0); PG8_BAR; PG8_MMA(0, 0, At, B0); PG8_MMA(0, 1, At, B1); PG8_BAR; PG8_SCHED;
            PG8_LDA(At, 0, 1); PG8_STAGE(PG8_SB(0, 0), b2, voffB); PG8_STAGE(PG8_SB(0, 1), b2 + hstepB, voffB); PG8_STAGE(PG8_SA(0, 0), a2, voffA);
            PG8_WAIT_V(8); PG8_WAIT_L(0); PG8_BAR; PG8_MMA(1, 0, At, B0); PG8_MMA(1, 1, At, B1); PG8_BAR; PG8_SCHED;
            PG8_LDB(B0, 1, 0); PG8_LDB(B1, 1, 1); PG8_SCHED; PG8_LDA(At, 1, 0); PG8_STAGE(PG8_SA(0, 1), a2 + hstepA, voffA);
            PG8_WAIT_V(8); PG8_WAIT_L(0); PG8_BAR; PG8_MMA(0, 0, At, B0); PG8_MMA(0, 1, At, B1); PG8_BAR; PG8_SCHED;
            PG8_LDA(At, 1, 1); PG8_STAGE(PG8_SB(1, 0), b3, voffB); PG8_STAGE(PG8_SB(1, 1), b3 + hstepB, voffB); PG8_STAGE(PG8_SA(1, 0), a3, voffA);
            PG8_WAIT_V(8); PG8_WAIT_L(0); PG8_BAR; PG8_MMA(1, 0, At, B0); PG8_MMA(1, 1, At, B1); PG8_BAR; PG8_SCHED;
            } else {
            PG8_LDB(B0, 0, 0); PG8_SCHED; PG8_LDA(At, 0, 0); PG8_STAGE(PG8_SA(1, 1), a1 + hstepA, voffA);
            PG8_WAIT_L(8); PG8_BAR; PG8_WAIT_L(0); PG8_MMA(0, 0, At, B0); PG8_BAR; PG8_SCHED;
            PG8_LDB(B1, 0, 1); PG8_STAGE(PG8_SB(0, 0), b2, voffB);
            PG8_BAR; PG8_WAIT_L(0); PG8_MMA(0, 1, At, B1); PG8_BAR;
            PG8_LDA(At, 0, 1); PG8_STAGE(PG8_SA(0, 0), a2, voffA);
            PG8_BAR; PG8_WAIT_L(0); PG8_MMA(1, 0, At, B0); PG8_BAR; PG8_SCHED;
            PG8_STAGE(PG8_SB(0, 1), b2 + hstepB, voffB);
            PG8_WAIT_V(6); PG8_BAR; PG8_MMA(1, 1, At, B1); PG8_BAR;
            PG8_LDB(B0, 1, 0); PG8_SCHED; PG8_LDA(At, 1, 0); PG8_STAGE(PG8_SA(0, 1), a2 + hstepA, voffA);
            PG8_WAIT_L(8); PG8_BAR; PG8_WAIT_L(0); PG8_MMA(0, 0, At, B0); PG8_BAR; PG8_SCHED;
            PG8_LDB(B1, 1, 1); PG8_STAGE(PG8_SB(1, 0), b3, voffB);
            PG8_BAR; PG8_WAIT_L(0); PG8_MMA(0, 1, At, B1); PG8_BAR;
            PG8_LDA(At, 1, 1); PG8_STAGE(PG8_SA(1, 0), a3, voffA);
            PG8_BAR; PG8_WAIT_L(0); PG8_MMA(1, 0, At, B0); PG8_BAR; PG8_SCHED;
            PG8_STAGE(PG8_SB(1, 1), b3 + hstepB, voffB);
            PG8_WAIT_V(6); PG8_BAR; PG8_MMA(1, 1, At, B1); PG8_BAR;
            }
        }
        if constexpr (ALIGN_EPI) { if (wr == 0) PG8_BAR; }
        if constexpr (!Epi::AFTER_DRAIN) { E(acc, cur, wr, wc, fr, fq); S.done(cur); }
        if (!has_next) break;
#pragma unroll
        for (int a = 0; a < 2; ++a)
#pragma unroll
            for (int b = 0; b < 2; ++b)
#pragma unroll
                for (int m = 0; m < 4; ++m)
#pragma unroll
                    for (int n = 0; n < 2; ++n) acc[a][b][m][n] = (f32x4){0.f, 0.f, 0.f, 0.f};
        cur = nxt; cA = nA; cB = nB; ++ui;
        if constexpr (ALIGN_EPI) { if (wr == 1) PG8_BAR; }
    }
    PG8_WAIT_V(0);
    if constexpr (!ALIGN_EPI) { if (wr == 0) PG8_BAR; }
    PG8_BAR;
    if constexpr (Epi::AFTER_DRAIN) { E.fused(acc, cur, wr, wc, fr, fq, lds, wid, lane); S.done(cur); }
#undef PG8_SA
#undef PG8_SB
#undef PG8_STAGE
#undef PG8_LDA
#undef PG8_LDB
#undef PG8_MMA
#undef PG8_WAIT_V
#undef PG8_WAIT_L
#undef PG8_BAR
#undef PG8_SCHED
}
}
#include <hip/hip_bf16.h>
#include <cmath>
namespace attn_body {
using bf16=__hip_bfloat16;
using bf16x8=__attribute__((ext_vector_type(8)))short;
using s16x4=__attribute__((ext_vector_type(4)))short;
using f32x16=__attribute__((ext_vector_type(16)))float;
using u32x4=__attribute__((ext_vector_type(4)))unsigned;
using f32x4a=__attribute__((ext_vector_type(4)))float;
constexpr int BATCH=4,NHEAD=16,SEQ=4096,D=64,DM=4096;
constexpr int NW=8,QBLK=32,QB=QBLK*NW,KVBLK=64,NQB=SEQ/QB;
constexpr int ATTN_PITCH=DM, ATTN_UNIT_ROWS=QB;
__device__ __forceinline__ int crow(int r,int hi){return (r&3)+8*(r>>2)+4*hi;}
#define SBAR() __builtin_amdgcn_sched_barrier(0)
__device__ __forceinline__ void cmask(f32x16&p0,f32x16&p1,int jb,int qrel,int hi){
  const float NEG=-INFINITY; int kb=64*jb+4*hi;
  #pragma unroll
  for(int r=0;r<16;++r){int kv=kb+(r&3)+8*(r>>2); if(kv>qrel)p0[r]=NEG; if(kv+32>qrel)p1[r]=NEG;}
}

constexpr int NSLOT=3, SLOTB=8192;
constexpr int LDS_K=0, LDS_V=NSLOT*SLOTB, LDS_WS=2*NSLOT*SLOTB, LDS_OST=LDS_WS+NW*64*4, LDS_CB=LDS_OST+NW*4096, LDS_BYTES=LDS_CB+NW*768;
constexpr float C2=0.125f*1.4426950408889634f;
__device__ __forceinline__ void glds16(const void*gsrc,unsigned lds_dst){unsigned keep;
  asm volatile("s_mov_b32 %0, m0\n\ts_mov_b32 m0, %2\n\ts_nop 0\n\tglobal_load_lds_dwordx4 %1, off\n\ts_mov_b32 m0, %0":"=&s"(keep):"v"(gsrc),"s"(lds_dst):"memory");}
__device__ __forceinline__ void glds4(const void*gsrc,unsigned lds_dst){unsigned keep;
  asm volatile("s_mov_b32 %0, m0\n\ts_mov_b32 m0, %2\n\ts_nop 0\n\tglobal_load_lds_dword %1, off\n\ts_mov_b32 m0, %0":"=&s"(keep):"v"(gsrc),"s"(lds_dst):"memory");}
__device__ __forceinline__ float max3f(float a,float b,float c){float r;asm("v_max3_f32 %0, %1, %2, %3":"=v"(r):"v"(a),"v"(b),"v"(c));return r;}
__device__ __forceinline__ float max2f(float a,float b){float r;asm("v_max_f32_e32 %0, %1, %2":"=v"(r):"v"(a),"v"(b));return r;}
__device__ __forceinline__ float fadd_s(float a,float b){float r;asm("v_add_f32_e32 %0, %1, %2":"=v"(r):"v"(a),"v"(b));return r;}
__device__ __forceinline__ float fsub_s(float a,float b){float r;asm("v_sub_f32_e32 %0, %1, %2":"=v"(r):"v"(a),"v"(b));return r;}
typedef float f32x2_t __attribute__((ext_vector_type(2))); typedef __bf16 bf16x2_t __attribute__((ext_vector_type(2)));
__device__ __forceinline__ unsigned cvtpk_s(float lo,float hi){f32x2_t v={lo,hi};bf16x2_t b=__builtin_convertvector(v,bf16x2_t);return __builtin_bit_cast(unsigned,b);}
#define WAIT_BAR(N) asm volatile("s_waitcnt vmcnt(" #N ") lgkmcnt(0)\n\ts_barrier":::"memory")

__device__ __forceinline__ void qkt(f32x16&p0,f32x16&p1,const char*Kslot,const bf16x8*qr,int r32,int hi){
  const char*kb=Kslot+hi*1024+r32*16;
  #pragma unroll
  for(int d0=0;d0<4;++d0){
    const bf16x8 b0=*reinterpret_cast<const bf16x8*>(kb+d0*2048);
    const bf16x8 b1=*reinterpret_cast<const bf16x8*>(kb+d0*2048+512);
    p0=__builtin_amdgcn_mfma_f32_32x32x16_bf16(b0,qr[d0],p0,0,0,0);p1=__builtin_amdgcn_mfma_f32_32x32x16_bf16(b1,qr[d0],p1,0,0,0);}
}
typedef __attribute__((address_space(3))) const char* lds_cptr;
typedef short v4i16_t __attribute__((ext_vector_type(4)));
__device__ __forceinline__ void kload8(bf16x8*kf,lds_cptr kp){
  kf[0]=*(const __attribute__((address_space(3))) bf16x8*)(kp);      kf[1]=*(const __attribute__((address_space(3))) bf16x8*)(kp+512);
  kf[2]=*(const __attribute__((address_space(3))) bf16x8*)(kp+2048); kf[3]=*(const __attribute__((address_space(3))) bf16x8*)(kp+2560);
  kf[4]=*(const __attribute__((address_space(3))) bf16x8*)(kp+4096); kf[5]=*(const __attribute__((address_space(3))) bf16x8*)(kp+4608);
  kf[6]=*(const __attribute__((address_space(3))) bf16x8*)(kp+6144); kf[7]=*(const __attribute__((address_space(3))) bf16x8*)(kp+6656);
}
__device__ __forceinline__ void kload2(bf16x8*kf,lds_cptr kp,int j){ kf[2*j]=*(const __attribute__((address_space(3))) bf16x8*)(kp+j*2048); kf[2*j+1]=*(const __attribute__((address_space(3))) bf16x8*)(kp+j*2048+512); }
__device__ __forceinline__ s16x4 vtr(lds_cptr p){ return __builtin_bit_cast(s16x4,__builtin_amdgcn_ds_read_tr16_b64_v4i16((__attribute__((address_space(3))) v4i16_t*)p)); }
__device__ __forceinline__ float rowmax(const f32x16&p0,const f32x16&p1){
  float a=max3f(p0[0],p0[1],p1[0]),b=max3f(p0[2],p0[3],p1[1]);a=max3f(a,p1[2],p1[3]);
  #pragma unroll
  for(int r=4;r<16;r+=4){a=max3f(a,p0[r],p0[r+1]);b=max3f(b,p0[r+2],p0[r+3]);a=max3f(a,p1[r],p1[r+1]);b=max3f(b,p1[r+2],p1[r+3]);}
  const float m=max2f(a,b);
  auto rr=__builtin_amdgcn_permlane32_swap(__float_as_uint(m),__float_as_uint(m),false,false);
  return max2f(__uint_as_float(rr[0]),__uint_as_float(rr[1]));
}
__device__ __forceinline__ void pv(f32x16*o,int vb,bf16x8 pa0,bf16x8 pa1,bf16x8 pa2,bf16x8 pa3){
  #pragma unroll
  for(int d0=0;d0<2;++d0){s16x4 lo[4],hi[4];
    #pragma unroll
    for(int ks=0;ks<4;++ks){
      asm volatile("ds_read_b64_tr_b16 %0,%1 offset:%c2":"=&v"(lo[ks]):"v"(vb),"i"(d0*4096+ks*1024):"memory");
      asm volatile("ds_read_b64_tr_b16 %0,%1 offset:%c2":"=&v"(hi[ks]):"v"(vb),"i"(d0*4096+ks*1024+512):"memory");}
    asm volatile("s_waitcnt lgkmcnt(0)":::"memory");SBAR();
    #define PK(k) (bf16x8){lo[k][0],lo[k][1],lo[k][2],lo[k][3],hi[k][0],hi[k][1],hi[k][2],hi[k][3]}
    o[d0]=__builtin_amdgcn_mfma_f32_32x32x16_bf16(pa0,PK(0),o[d0],0,0,0);
    o[d0]=__builtin_amdgcn_mfma_f32_32x32x16_bf16(pa1,PK(1),o[d0],0,0,0);
    o[d0]=__builtin_amdgcn_mfma_f32_32x32x16_bf16(pa2,PK(2),o[d0],0,0,0);
    o[d0]=__builtin_amdgcn_mfma_f32_32x32x16_bf16(pa3,PK(3),o[d0],0,0,0);
    #undef PK
  }
}

#ifndef ATTN_STORE16
#define ATTN_STORE16(p,v) (*(u32x4*)(p)=(v))
#endif
template<int THRL> __device__ __forceinline__ void attn_unit(int b,int h,int qb,const bf16*Q,const bf16*__restrict__ K,const bf16*__restrict__ V,const bf16*__restrict__ G,const float*__restrict__ CF,bf16*O,char*shm,const int wid,const float bnd2  ,const bool do_store=true){
  const int lane=lane_id(),r32=lane&31,hi=lane>>5;
  const long rowbase=(long)b*SEQ; const int q0=qb*QB;
  const bf16*Qw=Q+(rowbase+q0+wid*QBLK)*DM+h*D;
  const float*CFh=CF+(long)(b*NHEAD+h)*SEQ;
  int ts; { const int NT0=(q0+QB)/KVBLK; const float cq0=CFh[q0]; const float ce=CFh[64*(lane<NT0?lane:0)+63];
    const unsigned long long bm=__ballot((lane<NT0-4)&&(cq0-ce+bnd2<-60.f)); ts=__builtin_amdgcn_readfirstlane((int)__builtin_ctzll(~bm))&~1; }
  const bf16*Kh=K+(rowbase+(long)ts*KVBLK)*DM+h*D,*Vh=V+(rowbase+(long)ts*KVBLK)*DM+h*D;
  const unsigned lds0=(unsigned)(uintptr_t)shm;
  float*wsf=(float*)(shm+LDS_WS)+wid*64;
  const bf16*ksrc=Kh+(long)lane*DM+wid*8;
  const bf16*vsrc=Vh+(long)(16*(wid&3)+(lane>>2))*DM+(wid>>2)*32+(lane&3)*8;
  const unsigned kdst=lds0+LDS_K+wid*1024, vdst=lds0+LDS_V+wid*1024, cdst=lds0+LDS_CB+wid*768; const float*csrc=CFh+ts*KVBLK+lane;
  #define DMA_K(t,slot) do{ glds16(ksrc+(long)(t)*KVBLK*DM,(unsigned)__builtin_amdgcn_readfirstlane(kdst+(slot))); glds4(csrc+(t)*KVBLK,(unsigned)__builtin_amdgcn_readfirstlane(cdst+((slot)>>5))); }while(0)
  #define DMA_V(t,slot) glds16(vsrc+(long)(t)*KVBLK*DM,(unsigned)__builtin_amdgcn_readfirstlane(vdst+(slot)))
  const int vb0=(int)(lds0+LDS_V)+((lane>>4)&1)*32+(lane&3)*8+(4*hi+((lane&15)>>2))*64;
  const char*Kbase=shm+LDS_K; bf16x8 kf[8];
  const lds_cptr shm3=(lds_cptr)shm; const lds_cptr kp0=shm3+LDS_K+hi*1024+r32*16; const lds_cptr vp0=shm3+LDS_V+((lane>>4)&1)*32+(lane&3)*8+(4*hi+((lane&15)>>2))*64;
  const int NT=(q0+QB)/KVBLK-ts;
  DMA_K(0,0);DMA_V(0,0);DMA_K(1,SLOTB);
  bf16x8 qr[4];
  #pragma unroll
  for(int d0=0;d0<4;++d0)qr[d0]=*reinterpret_cast<const bf16x8*>(&Qw[(long)r32*DM+d0*16+hi*8]);
  float mhat=0.f,l_reg=0.f;f32x16 o[2];o[0]=f32x16{};o[1]=f32x16{};
  float nb=CFh[q0+wid*QBLK+r32];
  const lds_cptr cbp0=(lds_cptr)shm+LDS_CB+wid*768+hi*16;
  #define CINIT(C0,C1,slot) do{ const lds_cptr cb_=cbp0+((slot)>>5); _Pragma("unroll") for(int g_=0;g_<4;++g_){ \
      const f32x4a a_=*(const __attribute__((address_space(3))) f32x4a*)(cb_+32*g_), b_=*(const __attribute__((address_space(3))) f32x4a*)(cb_+128+32*g_); \
      _Pragma("unroll") for(int i_=0;i_<4;++i_){ C0[4*g_+i_]=nb-a_[i_]; C1[4*g_+i_]=nb-b_[i_]; } } }while(0)
  const int qrel=wid*QBLK+r32;
  #define CMASK(P0,P1,t) do{int jb_=(t)-(NT-4); if(jb_>=0)cmask(P0,P1,jb_,qrel,hi);}while(0)
  bool resc=false;
  #define START(P0,P1) do{ const float rm=rowmax(P0,P1); resc=false; \
    { const float dl=rm; mhat=fadd_s(mhat,dl); \
      _Pragma("unroll") for(int r=0;r<16;++r){P0[r]=fsub_s(P0[r],dl);P1[r]=fsub_s(P1[r],dl);} \
      nb-=dl; } \
    _Pragma("unroll") for(int r=0;r<16;++r)P0[r]=__builtin_amdgcn_exp2f(P0[r]); }while(0)
  #define RESC() do{ if(resc){ asm volatile("s_waitcnt lgkmcnt(0)":::"memory"); \
      _Pragma("unroll") for(int d_=0;d_<2;++d_) _Pragma("unroll") for(int r=0;r<16;++r)o[d_][r]*=wsf[crow(r,hi)]; } }while(0)
  f32x16 pA0,pA1,pB0,pB1;
  int sl_prev=0,sl_cur=0,sl_next=SLOTB;
  #define ROT() do{sl_prev=sl_cur;sl_cur=sl_next;sl_next=(sl_next==(NSLOT-1)*SLOTB)?0:sl_next+SLOTB;}while(0)
  DMA_K(2,2*SLOTB);
  WAIT_BAR(3);
  CINIT(pA0,pA1,0); qkt(pA0,pA1,Kbase,qr,r32,hi);asm volatile("s_nop 15\n\ts_nop 7":"+v"(pA0),"+v"(pA1));CMASK(pA0,pA1,0);
  START(pA0,pA1);
  _Pragma("unroll") for(int r=0;r<16;++r)pA1[r]=__builtin_amdgcn_exp2f(pA1[r]);
  WAIT_BAR(0);
  DMA_K(3,0);DMA_V(1,SLOTB);
  ROT();
  kload8(kf,kp0+sl_cur);
  WAIT_BAR(3);
  s16x4 vlo[8],vhi[8]; u32x4 pw0,pw1,pw2,pw3;
  #define PKW(P,B) cvtpk_s(P[B],P[B+1])
  #define PAF(k) __builtin_bit_cast(bf16x8,pw##k)
  #define VFR(i) (bf16x8){vlo[i][0],vlo[i][1],vlo[i][2],vlo[i][3],vhi[i][0],vhi[i][1],vhi[i][2],vhi[i][3]}
  #define PIN(x) asm volatile("":"+v"(x))
  #define MX3(a,b,c) __builtin_fmaxf(__builtin_fmaxf((a),(b)),(c))
  #define GAPA(MF,A0,A1,A2,A3,W0,W1,PW) do{ MF; sacc+=A0; sacc+=A1; sacc+=A2; sacc+=A3; PIN(sacc); W0; W1; PIN(PW); SBAR(); }while(0)
  #define EX(v) __builtin_amdgcn_exp2f(v)
  #define GAPB(MF,X,B) do{ MF; X[B]=EX(X[B]); X[B+1]=EX(X[B+1]); X[B+2]=EX(X[B+2]); X[B+3]=EX(X[B+3]); PIN(X); SBAR(); }while(0)
  #define VRD(i) do{ vlo[i]=vtr(vp_+(((i)>>2)*4096+((i)&3)*1024)); vhi[i]=vtr(vp_+(((i)>>2)*4096+((i)&3)*1024+512)); }while(0)
  #define KRD(G,j) do{ if(G){ kload2(kf,kp0+sl_next,j); SBAR(); } }while(0)
  #define STEP(C0,C1,P0,P1,t,GK,GV,GL) do{ SBAR(); \
    CINIT(C0,C1,sl_cur); SBAR(); \
    const lds_cptr vp_=vp0+sl_prev; \
    VRD(0); SBAR(); float sacc=(P0[0]+P0[1]); \
    GAPA(C0=__builtin_amdgcn_mfma_f32_32x32x16_bf16(kf[0],qr[0],C0,0,0,0), P0[2],P0[3],P0[4],P0[5],     pw0[0]=PKW(P0,0), pw0[1]=PKW(P0,2), pw0); \
    VRD(4); SBAR(); GAPA(C1=__builtin_amdgcn_mfma_f32_32x32x16_bf16(kf[1],qr[0],C1,0,0,0), P0[6],P0[7],P0[8],P0[9],     pw0[2]=PKW(P0,4), pw0[3]=PKW(P0,6), pw0); \
    VRD(1); SBAR(); GAPA(C0=__builtin_amdgcn_mfma_f32_32x32x16_bf16(kf[2],qr[1],C0,0,0,0),   P0[10],P0[11],P0[12],P0[13], pw1[0]=PKW(P0,8), pw1[1]=PKW(P0,10), pw1); \
    VRD(5); SBAR(); GAPA(C1=__builtin_amdgcn_mfma_f32_32x32x16_bf16(kf[3],qr[1],C1,0,0,0),   P0[14],P0[15],P1[0],P1[1],   pw1[2]=PKW(P0,12),pw1[3]=PKW(P0,14), pw1); \
    VRD(2); SBAR(); GAPA(C0=__builtin_amdgcn_mfma_f32_32x32x16_bf16(kf[4],qr[2],C0,0,0,0),   P1[2],P1[3],P1[4],P1[5],     pw2[0]=PKW(P1,0), pw2[1]=PKW(P1,2), pw2); \
    VRD(6); SBAR(); GAPA(C1=__builtin_amdgcn_mfma_f32_32x32x16_bf16(kf[5],qr[2],C1,0,0,0),   P1[6],P1[7],P1[8],P1[9],     pw2[2]=PKW(P1,4), pw2[3]=PKW(P1,6), pw2); \
    VRD(3); SBAR(); GAPA(C0=__builtin_amdgcn_mfma_f32_32x32x16_bf16(kf[6],qr[3],C0,0,0,0),   P1[10],P1[11],P1[12],P1[13], pw3[0]=PKW(P1,8), pw3[1]=PKW(P1,10), pw3); \
    VRD(7); SBAR(); GAPA(C1=__builtin_amdgcn_mfma_f32_32x32x16_bf16(kf[7],qr[3],C1,0,0,0),   P1[14],P1[15],0.f,0.f,       pw3[2]=PKW(P1,12),pw3[3]=PKW(P1,14), pw3); \
    l_reg+=sacc; \
    if(GK){DMA_K((t)+3,sl_cur);} if(GV){DMA_V((t)+1,sl_next);} \
    CMASK(C0,C1,t); \
    { float a=MX3(C0[0],C0[1],C1[0]),b=MX3(C0[2],C0[3],C1[1]); a=MX3(a,C1[2],C1[3]); \
      _Pragma("unroll") for(int r=4;r<16;r+=4){a=MX3(a,C0[r],C0[r+1]);b=MX3(b,C0[r+2],C0[r+3]);a=MX3(a,C1[r],C1[r+1]);b=MX3(b,C1[r+2],C1[r+3]);} \
      float rm=__builtin_fmaxf(a,b); { auto rr=__builtin_amdgcn_permlane32_swap(__float_as_uint(rm),__float_as_uint(rm),false,false); rm=__builtin_fmaxf(__uint_as_float(rr[0]),__uint_as_float(rr[1])); } \
      resc=false; \
      if(__builtin_expect(__any(rm>(float)THRL),0)){ const float dl=__builtin_fmaxf(rm,0.f); mhat+=dl; \
        _Pragma("unroll") for(int r=0;r<16;++r){C0[r]-=dl;C1[r]-=dl;} \
        nb-=dl; \
        const float f=__builtin_amdgcn_exp2f(-dl); l_reg*=f; if(hi==0)wsf[r32]=f; resc=true; } } \
    SBAR(); \
    GAPB(o[0]=__builtin_amdgcn_mfma_f32_32x32x16_bf16(PAF(0),VFR(0),o[0],0,0,0), C0,0); \
    GAPB(o[1]=__builtin_amdgcn_mfma_f32_32x32x16_bf16(PAF(0),VFR(4),o[1],0,0,0), C0,4); \
    KRD(GL,0); GAPB(o[0]=__builtin_amdgcn_mfma_f32_32x32x16_bf16(PAF(1),VFR(1),o[0],0,0,0), C0,8); \
    KRD(GL,1); GAPB(o[1]=__builtin_amdgcn_mfma_f32_32x32x16_bf16(PAF(1),VFR(5),o[1],0,0,0), C0,12); \
    KRD(GL,2); GAPB(o[0]=__builtin_amdgcn_mfma_f32_32x32x16_bf16(PAF(2),VFR(2),o[0],0,0,0), C1,0); \
    KRD(GL,3); GAPB(o[1]=__builtin_amdgcn_mfma_f32_32x32x16_bf16(PAF(2),VFR(6),o[1],0,0,0), C1,4); \
    GAPB(o[0]=__builtin_amdgcn_mfma_f32_32x32x16_bf16(PAF(3),VFR(3),o[0],0,0,0), C1,8); \
    GAPB(o[1]=__builtin_amdgcn_mfma_f32_32x32x16_bf16(PAF(3),VFR(7),o[1],0,0,0), C1,12); \
    }while(0)
  int t=1;
  #undef CMASK
  #define CMASK(P0,P1,t) do{}while(0)
  for(;t+5<NT;t+=2){
    STEP(pB0,pB1,pA0,pA1,t,true,true,true);     WAIT_BAR(3); RESC(); ROT();
    STEP(pA0,pA1,pB0,pB1,t+1,true,true,true);   WAIT_BAR(3); RESC(); ROT();
  }
  #undef CMASK
  #define CMASK(P0,P1,t) do{int jb_=(t)-(NT-4); if(jb_>=0)cmask(P0,P1,jb_,qrel,hi);}while(0)
  #define ENDW(tt) do{ if((tt)+3<NT){WAIT_BAR(3);} else if((tt)+2<NT){WAIT_BAR(1);} else {WAIT_BAR(0);} }while(0)
  for(;t+1<NT;t+=2){
    STEP(pB0,pB1,pA0,pA1,t,(t+3<NT),(t+1<NT),(t+1<NT));       ENDW(t);   RESC(); ROT();
    STEP(pA0,pA1,pB0,pB1,t+1,(t+4<NT),(t+2<NT),(t+2<NT));     ENDW(t+1); RESC(); ROT();
  }
  STEP(pB0,pB1,pA0,pA1,NT-1,false,false,false); RESC();
  { float sacc=pB0[0]+pB0[1]; _Pragma("unroll") for(int r=2;r<16;++r)sacc+=pB0[r]; _Pragma("unroll") for(int r=0;r<16;++r)sacc+=pB1[r]; l_reg+=sacc;
    pw0=(u32x4){PKW(pB0,0),PKW(pB0,2),PKW(pB0,4),PKW(pB0,6)};pw1=(u32x4){PKW(pB0,8),PKW(pB0,10),PKW(pB0,12),PKW(pB0,14)};pw2=(u32x4){PKW(pB1,0),PKW(pB1,2),PKW(pB1,4),PKW(pB1,6)};pw3=(u32x4){PKW(pB1,8),PKW(pB1,10),PKW(pB1,12),PKW(pB1,14)};
    SBAR(); pv(o,vb0+sl_cur,PAF(0),PAF(1),PAF(2),PAF(3)); }
  #undef PKW
  #undef PAF
  #undef VFR
  #undef PIN
  #undef MX3
  #undef GAPA
  #undef GAPB
  #undef EX
  #undef VRD
  #undef KRD
  #undef STEP
  #undef ENDW
  {auto rr=__builtin_amdgcn_permlane32_swap(__float_as_uint(l_reg),__float_as_uint(l_reg),false,false);l_reg=__uint_as_float(rr[0])+__uint_as_float(rr[1]);}
  if(hi==0)wsf[32+r32]=l_reg;asm volatile("s_waitcnt lgkmcnt(0)":::"memory");
  float rli[16];
  #pragma unroll
  for(int r=0;r<16;++r)rli[r]=__builtin_amdgcn_rcpf(wsf[32+crow(r,hi)]);
  bf16*Ow=O+(rowbase+q0+wid*QBLK)*DM+h*D;
  { bf16*stg=(bf16*)(shm+LDS_OST)+wid*2048;
    #pragma unroll
    for(int r=0;r<16;++r){const int orow=crow(r,hi);
      #pragma unroll
      for(int d0=0;d0<2;++d0)stg[orow*64+d0*32+r32]=__float2bfloat16(o[d0][r]*rli[r]);}
    asm volatile("s_waitcnt lgkmcnt(0)":::"memory");
    const bf16*Gw=G+(rowbase+q0+wid*QBLK)*DM+h*D;
    #pragma unroll
    for(int i=0;i<4;++i){const int row=i*8+(lane>>3),ch=lane&7; const u32x4 v=*(const u32x4*)(stg+row*64+ch*8); const u32x4 gv=*(const u32x4*)(Gw+(long)row*DM+ch*8); u32x4 w;
      #pragma unroll
      for(int e=0;e<4;++e){ const float o0=__uint_as_float(v[e]<<16),o1=__uint_as_float(v[e]&0xffff0000u),g0=__uint_as_float(gv[e]<<16),g1=__uint_as_float(gv[e]&0xffff0000u);
        const float s0=g0*__builtin_amdgcn_rcpf(1.f+__builtin_amdgcn_exp2f(-1.4426950408889634f*g0)),s1=g1*__builtin_amdgcn_rcpf(1.f+__builtin_amdgcn_exp2f(-1.4426950408889634f*g1)); w[e]=cvtpk_s(o0*s0,o1*s1); }
      if(do_store)ATTN_STORE16(Ow+(long)row*DM+ch*8,w);} }
  asm volatile("s_waitcnt lgkmcnt(0)\n\ts_barrier":::"memory");
  #undef DMA_K
  #undef CINIT
  #undef DMA_V
  #undef CMASK
  #undef START
  #undef RESC
  #undef ROT
}
constexpr int ATTN_LDS_BYTES=LDS_BYTES;
#undef SBAR
#undef WAIT_BAR
}
namespace scan2 {
#define S2_LAS __attribute__((address_space(3)))
typedef float f32x4 __attribute__((ext_vector_type(4)));
typedef float f32x2 __attribute__((ext_vector_type(2)));
typedef unsigned u32x2 __attribute__((ext_vector_type(2)));
constexpr int T = 4096, C = 16, NCH = T / C, RS = 272  , R20 = 80  ;
constexpr int O_ALPHA = 0, O_RHO = 4352, O_NBETA = 8704, O_KAPPA = 13056, O_VROW = 17408, O_G15 = 21760, SLOT3 = 22016;
constexpr int O_S2 = 3 * SLOT3, O_KAT = 0, O_NRT = 1280, O_KRT = 2560, O_NN = 3840  , O_NNT = 5120  , SLOT2 = 6400;
constexpr int O_WTOT = O_S2 + 2 * SLOT2  , O_YB = O_WTOT + 2048  ;
constexpr int O_PB4 = O_YB + 8192  , PB4 = 8256, O_END = O_PB4 + 4 * PB4, LDS_BYTES = O_END;
template <int CTRL> __device__ __forceinline__ float dppf(float x) { return __builtin_bit_cast(float, __builtin_amdgcn_mov_dpp(__builtin_bit_cast(int, x), CTRL, 0xF, 0xF, true)); }
__device__ __forceinline__ float red16(float x) { x += dppf<0xB1>(x); x += dppf<0x4E>(x); x += dppf<0x141>(x); x += dppf<0x140>(x); return x; }
__device__ __forceinline__ f32x4 bf4(u32x2 u) { return (f32x4){__uint_as_float(u.x << 16), __uint_as_float(u.x & 0xffff0000u), __uint_as_float(u.y << 16), __uint_as_float(u.y & 0xffff0000u)}; }
__device__ __forceinline__ float dot4(f32x4 a, f32x4 b) { return (a.x * b.x + a.y * b.y) + (a.z * b.z + a.w * b.w); }
__device__ __forceinline__ unsigned pkbf(float lo, float hi) { typedef __bf16 b2 __attribute__((ext_vector_type(2))); f32x2 v = {lo, hi}; return __builtin_bit_cast(unsigned, __builtin_convertvector(v, b2)); }
#define S2_MFMA(a, b, c) __builtin_amdgcn_mfma_f32_16x16x4f32((a), (b), (c), 0, 0, 0)
#define S2_LD4(off) (*(const S2_LAS f32x4*)(lds + (off)))
#define S2_LD1(off) (*(const S2_LAS float*)(lds + (off)))
struct Params { const unsigned short* ZRW; const unsigned short* DEC; const unsigned short* AG; unsigned short* YR; const float* mu; const float* k_k; const float* k_a; const float* r_k; const float* ln_g; const float* ln_b; };
struct Raw { u32x2 zr, zk, zv, zg, pr, pk, pv, pg, ag, dech; };

__device__ __forceinline__ void scan_head(S2_LAS unsigned char* lds, const Params& P, int bh, const int wid, unsigned long long* tsout = nullptr) {
    unsigned long long twait = 0;
    const int lane = lane_id(), li = lane & 15, lg = lane >> 4;
    const int b = bh >> 4, h = bh & 15;
#define S2_BAR() do { const unsigned long long t0_ = tsout ? __builtin_amdgcn_s_memrealtime() : 0ull; __syncthreads(); if (tsout) twait += __builtin_amdgcn_s_memrealtime() - t0_; } while (0)
    __syncthreads();
    if (wid < 4) {
        const int wv = wid, t = 4 * wid + lg, c4 = li, colh = h * 64 + 4 * c4;
        const f32x4 lng = *(const f32x4*)(P.ln_g + colh), lnb = *(const f32x4*)(P.ln_b + colh);
        f32x4 St[4] = {{0.f, 0.f, 0.f, 0.f}, {0.f, 0.f, 0.f, 0.f}, {0.f, 0.f, 0.f, 0.f}, {0.f, 0.f, 0.f, 0.f}};
#define S2_POST(cc) do { const int po = O_PB4 + ((cc) & 3) * PB4; \
        const f32x4 y4 = S2_LD4(O_YB + ((cc) & 1) * 4096 + t * 256 + c4 * 16); \
        const float mean = red16((y4.x + y4.y) + (y4.z + y4.w)) * (1.f / 64.f); const f32x4 d = y4 - mean; \
        const float var = red16(dot4(d, d)) * (1.f / 64.f); const float rs_ = __builtin_amdgcn_rsqf(var + 64e-5f); \
        const f32x4 v4 = S2_LD4(po + t * 256 + c4 * 16), gs4 = S2_LD4(po + 4096 + t * 256 + c4 * 16); const float kb = S2_LD1(po + 8192 + t * 4); \
        f32x4 sg4; _Pragma("unroll") for (int e = 0; e < 4; ++e) sg4[e] = gs4[e] * __builtin_amdgcn_rcpf(1.f + __builtin_amdgcn_exp2f(-1.4426950408889634f * gs4[e])); \
        const f32x4 o = ((d * rs_) * lng + lnb + kb * v4) * sg4; \
        const size_t m_ = (size_t)b * T + (cc) * C + t; \
        *(u32x2*)(P.YR + m_ * 1024 + colh) = (u32x2){pkbf(o.x, o.y), pkbf(o.z, o.w)}; } while (0)
        __syncthreads(); __syncthreads(); __syncthreads();
        int s3 = 0;
        const int cb = li & 7, bb = li >> 3; const bool lo8 = li < 8, g01 = lg < 2;
        f32x4 dl; _Pragma("unroll") for (int ks = 0; ks < 4; ++ks) dl[ks] = (li == 4 * lg + ks) ? 1.f : 0.f;
#pragma unroll 1
        for (int c = 0; c < NCH; ++c) {
            const int so = s3 * SLOT3, s2o = O_S2 + (c & 1) * SLOT2;
            f32x4 RH = {0.f, 0.f, 0.f, 0.f}, Y0 = RH, Ut = RH;
            float Tb[8];
            {
                f32x4 al[4], ro[4];
#pragma unroll
                for (int kb = 0; kb < 4; ++kb) { al[kb] = S2_LD4(so + O_ALPHA + li * RS + (16 * kb + 4 * lg) * 4); ro[kb] = S2_LD4(so + O_RHO + li * RS + (16 * kb + 4 * lg) * 4); }
#pragma unroll
                for (int idx = 0; idx < 16; ++idx) { const int kb = idx >> 2, r = idx & 3;
                    RH = S2_MFMA(al[kb][r], St[kb][r], RH); Y0 = S2_MFMA(ro[kb][r], St[kb][r], Y0);
                    if (idx < 8) { const int i_ = 7 - idx; float a0 = 0.f, a1 = 0.f;
                        if (i_ < 7) { const f32x4 n1 = S2_LD4(s2o + O_NN + (8 * bb + i_) * R20 + (8 * bb + 4) * 4);
#pragma unroll
                            for (int e = 0; e < 4; ++e) if (4 + e > i_) a1 += n1[e] * Tb[4 + e]; }
                        if (i_ < 3) { const f32x4 n0 = S2_LD4(s2o + O_NN + (8 * bb + i_) * R20 + (8 * bb) * 4);
#pragma unroll
                            for (int e = 0; e < 4; ++e) if (e > i_) a0 += n0[e] * Tb[e]; }
                        Tb[i_] = ((cb == i_) ? 1.f : 0.f) - (a0 + a1); } }
            }
            f32x4 qa, qb, qc;
            { const f32x4 nnt = S2_LD4(s2o + O_NNT + li * R20 + lg * 16);
#pragma unroll
              for (int ks = 0; ks < 4; ++ks) { const unsigned mk_ = 0u - (unsigned)(lg & 1); const float sel = __uint_as_float((__float_as_uint(Tb[4 + ks]) & mk_) | (__float_as_uint(Tb[ks]) & ~mk_));
                  qa[ks] = lo8 ? (g01 ? sel : 0.f) : dl[ks]; qc[ks] = lo8 ? dl[ks] : (g01 ? 0.f : sel); qb[ks] = (!lo8 && g01) ? nnt[ks] : dl[ks]; } }
            const f32x4 kaT = S2_LD4(s2o + O_KAT + li * R20 + lg * 16), nrT = S2_LD4(s2o + O_NRT + li * R20 + lg * 16), krT = S2_LD4(s2o + O_KRT + li * R20 + lg * 16);
            f32x4 vv;
#pragma unroll
            for (int ks = 0; ks < 4; ++ks) vv[ks] = S2_LD1(so + O_VROW + (4 * lg + ks) * RS + (16 * wv + li) * 4);
#pragma unroll
            for (int ks = 0; ks < 4; ++ks) RH = S2_MFMA(kaT[ks], vv[ks], RH);
            { f32x4 X1 = {0.f, 0.f, 0.f, 0.f}, X2 = X1;
#pragma unroll
              for (int ks = 0; ks < 4; ++ks) X1 = S2_MFMA(qa[ks], RH[ks], X1);
#pragma unroll
              for (int ks = 0; ks < 4; ++ks) X2 = S2_MFMA(qb[ks], X1[ks], X2);
#pragma unroll
              for (int ks = 0; ks < 4; ++ks) Ut = S2_MFMA(qc[ks], X2[ks], Ut); }
#pragma unroll
            for (int ks = 0; ks < 4; ++ks) { Y0 = S2_MFMA(nrT[ks], Ut[ks], Y0); Y0 = S2_MFMA(krT[ks], vv[ks], Y0); }
            {
                S2_LAS unsigned char* yb = lds + O_YB + (c & 1) * 4096 + (16 * wv + li) * 4;
#pragma unroll
                for (int r = 0; r < 4; ++r) *(S2_LAS float*)(yb + (4 * lg + r) * 256) = Y0[r];
            }
            {
                f32x4 nb[4], kq[4];
#pragma unroll
                for (int kb = 0; kb < 4; ++kb)
#pragma unroll
                    for (int ks = 0; ks < 4; ++ks) { nb[kb][ks] = S2_LD1(so + O_NBETA + (4 * lg + ks) * RS + (16 * kb + li) * 4); kq[kb][ks] = S2_LD1(so + O_KAPPA + (4 * lg + ks) * RS + (16 * kb + li) * 4); }
#pragma unroll
                for (int ks = 0; ks < 4; ++ks) {
#pragma unroll
                    for (int kb = 0; kb < 4; ++kb) St[kb] = S2_MFMA(nb[kb][ks], Ut[ks], St[kb]);
#pragma unroll
                    for (int kb = 0; kb < 4; ++kb) St[kb] = S2_MFMA(kq[kb][ks], vv[ks], St[kb]); }
                if (c >= 1) S2_POST(c - 1);
#pragma unroll
                for (int kb = 0; kb < 4; ++kb) St[kb] = St[kb] * S2_LD4(so + O_G15 + (16 * kb + 4 * lg) * 4);
            }
            s3 = (s3 == 2) ? 0 : s3 + 1;
            S2_BAR();
        }
        S2_POST(NCH - 1);
#undef S2_POST
        if (tsout && wid == 0 && lane == 0) { tsout[20] = twait; tsout[23] = 0ull; }
    } else {
        const int p = wid - 4, t = 4 * p + lg, c4 = li, colh = h * 64 + 4 * c4;
        const f32x4 mu_r = *(const f32x4*)(P.mu + colh), mu_k = *(const f32x4*)(P.mu + 1024 + colh), mu_v = *(const f32x4*)(P.mu + 2048 + colh), mu_g = *(const f32x4*)(P.mu + 3072 + colh);
        const f32x4 kkc = *(const f32x4*)(P.k_k + colh), kac = *(const f32x4*)(P.k_a + colh), rkc = *(const f32x4*)(P.r_k + colh);
        Raw R0, R1, R2;
        f32x4 ginC, gexC, ginN, gexN;
#define S2_LOAD(k, R) do { const int kk_ = (k) < NCH ? (k) : NCH - 1; const int t_ = kk_ * C + t; const size_t m_ = (size_t)b * T + t_; const unsigned short* z_ = P.ZRW + m_ * 4096 + colh; \
        R.zr = *(const u32x2*)(z_); R.zk = *(const u32x2*)(z_ + 1024); R.zv = *(const u32x2*)(z_ + 2048); R.zg = *(const u32x2*)(z_ + 3072); \
        if (t_ > 0) { R.pr = *(const u32x2*)(z_ - 4096); R.pk = *(const u32x2*)(z_ - 4096 + 1024); R.pv = *(const u32x2*)(z_ - 4096 + 2048); R.pg = *(const u32x2*)(z_ - 4096 + 3072); } \
        else { R.pr = (u32x2){0u, 0u}; R.pk = R.pr; R.pv = R.pr; R.pg = R.pr; } \
        R.dech = *(const u32x2*)(P.DEC + m_ * 1024 + colh); R.ag = *(const u32x2*)(P.AG + m_ * 1024 + colh); } while (0)
#define S2_W(k, R, gin, gex) do { typedef _Float16 h4_ __attribute__((ext_vector_type(4))); const h4_ dh_ = __builtin_bit_cast(h4_, R.dech); \
        gin = (f32x4){1.f - (float)dh_[0], 1.f - (float)dh_[1], 1.f - (float)dh_[2], 1.f - (float)dh_[3]}; \
        { f32x4 y_; _Pragma("unroll") for (int e = 0; e < 4; ++e) y_[e] = __shfl_up(gin[e], 16); if (lg >= 1) gin = gin * y_; \
          _Pragma("unroll") for (int e = 0; e < 4; ++e) y_[e] = __shfl_up(gin[e], 32); if (lg >= 2) gin = gin * y_; } \
        _Pragma("unroll") for (int e = 0; e < 4; ++e) gex[e] = __shfl_up(gin[e], 16); if (lg == 0) gex = (f32x4){1.f, 1.f, 1.f, 1.f}; \
        if (lg == 3) *(S2_LAS f32x4*)(lds + O_WTOT + ((k) & 1) * 1024 + p * 256 + c4 * 16) = gin; } while (0)
#define S2_A(k, s3k, R, gin, gex) do { const int so = (s3k) * SLOT3, po = O_PB4 + ((k) & 3) * PB4; \
        const f32x4 r_ = bf4(R.zr), k_ = bf4(R.zk), v_ = bf4(R.zv), g_ = bf4(R.zg); \
        const f32x4 rs = r_ + (bf4(R.pr) - r_) * mu_r, ks = k_ + (bf4(R.pk) - k_) * mu_k, vs = v_ + (bf4(R.pv) - v_) * mu_v, gs = g_ + (bf4(R.pg) - g_) * mu_g; \
        const f32x4 kkr = ks * kkc; const float n2 = red16(dot4(kkr, kkr)); const float inv = fminf(__builtin_amdgcn_rsqf(n2), 1e12f); const f32x4 kk = kkr * inv; \
        const f32x4 a_ = bf4(R.ag), kp = ks * (1.f + (a_ - 1.f) * kac), bv = kk * a_; \
        const float kb = red16(dot4(rs * kp, rkc)); \
        f32x4 gb = {1.f, 1.f, 1.f, 1.f}; for (int q_ = 0; q_ < p; ++q_) gb = gb * S2_LD4(O_WTOT + ((k) & 1) * 1024 + q_ * 256 + c4 * 16); \
        const f32x4 gm = gb * gin, gp = gb * gex; \
        f32x4 gi; _Pragma("unroll") for (int e = 0; e < 4; ++e) gi[e] = __builtin_amdgcn_rcpf(gm[e]); \
        *(S2_LAS f32x4*)(lds + so + O_ALPHA + t * RS + c4 * 16) = gp * kk; *(S2_LAS f32x4*)(lds + so + O_RHO + t * RS + c4 * 16) = gm * rs; \
        *(S2_LAS f32x4*)(lds + so + O_NBETA + t * RS + c4 * 16) = -(bv * gi); *(S2_LAS f32x4*)(lds + so + O_KAPPA + t * RS + c4 * 16) = kp * gi; \
        *(S2_LAS f32x4*)(lds + so + O_VROW + t * RS + c4 * 16) = vs; *(S2_LAS f32x4*)(lds + po + t * 256 + c4 * 16) = vs; *(S2_LAS f32x4*)(lds + po + 4096 + t * 256 + c4 * 16) = gs;     \
        if (c4 == 0) *(S2_LAS float*)(lds + po + 8192 + t * 4) = kb; if (t == C - 1) *(S2_LAS f32x4*)(lds + so + O_G15 + c4 * 16) = gm; } while (0)
#define S2_M1(k, s3k) do { const int so = (s3k) * SLOT3, s2o = O_S2 + ((k) & 1) * SLOT2; \
        f32x4 D = {0.f, 0.f, 0.f, 0.f}, D2 = D; const int xo = so + ((p < 2) ? O_NBETA : O_KAPPA) + li * RS + lg * 16, yo = so + ((p & 1) ? O_RHO : O_ALPHA) + li * RS + lg * 16; \
        _Pragma("unroll") for (int kb_ = 0; kb_ < 4; ++kb_) { const f32x4 xa = S2_LD4(xo + kb_ * 64), yb = S2_LD4(yo + kb_ * 64); \
            D = S2_MFMA(xa[0], yb[0], D); D2 = S2_MFMA(xa[1], yb[1], D2); D = S2_MFMA(xa[2], yb[2], D); D2 = S2_MFMA(xa[3], yb[3], D2); } \
        D = D + D2;     \
        f32x4 o; _Pragma("unroll") for (int r = 0; r < 4; ++r) { const int i_ = 4 * lg + r; const bool keep = (p & 1) ? (i_ <= li) : (i_ < li); o[r] = keep ? D[r] : 0.f; } \
        if (p == 0) { _Pragma("unroll") for (int r = 0; r < 4; ++r) *(S2_LAS float*)(lds + s2o + O_NN + (4 * lg + r) * R20 + li * 4) = -o[r]; *(S2_LAS f32x4*)(lds + s2o + O_NNT + li * R20 + lg * 16) = o; } \
        else *(S2_LAS f32x4*)(lds + s2o + ((p == 1) ? O_NRT : (p == 2) ? O_KAT : O_KRT) + li * R20 + lg * 16) = o; } while (0)
        S2_LOAD(0, R0); S2_LOAD(1, R1); S2_LOAD(2, R2);
        S2_W(0, R0, ginC, gexC); S2_W(1, R1, ginN, gexN);
        __syncthreads();
        S2_A(0, 0, R0, ginC, gexC); S2_A(1, 1, R1, ginN, gexN); S2_LOAD(3, R0);
        __syncthreads();
        S2_M1(0, 0); S2_W(2, R2, ginC, gexC);
        __syncthreads();
#define S2_INTERVAL(c, sA, sM, RA, RW, RL) do { \
        if ((c) + 1 < NCH) S2_M1((c) + 1, sM); \
        if ((c) + 2 < NCH) S2_A((c) + 2, sA, RA, ginC, gexC); \
        S2_W((c) + 3, RW, ginN, gexN); ginC = ginN; gexC = gexN; \
        S2_LOAD((c) + 4, RL); \
        S2_BAR(); } while (0)
#pragma unroll 1
        for (int c = 0; c < NCH; c += 3) {
            S2_INTERVAL(c, 2, 1, R2, R0, R1);
            if (c + 1 < NCH) S2_INTERVAL(c + 1, 0, 2, R0, R1, R2);
            if (c + 2 < NCH) S2_INTERVAL(c + 2, 1, 0, R1, R2, R0);
        }
        if (tsout && wid == 4 && lane == 0) { tsout[21] = twait; tsout[22] = 0ull; }
#undef S2_LOAD
#undef S2_W
#undef S2_A
#undef S2_M1
#undef S2_INTERVAL
    }
#undef S2_BAR
}
}
#include <hip/hip_cooperative_groups.h>
namespace cg = cooperative_groups;
#ifndef MK_PER_PHASE_LAUNCHES
#define MK_PER_PHASE_LAUNCHES 0
#endif
constexpr int NWAVES = 8, NTHREADS = NWAVES * 64;
constexpr int BATCH = 4, T = 4096, D = 2048, M = BATCH * T, C = 1024, H = 16, PLE = 256;
constexpr int N_IN = 12432, NZ = 12544;
constexpr float NORM_EPS = 1e-6f;
constexpr size_t MiB = 1u << 20;
constexpr size_t WS_CTL = 0, CTL_ZERO_BYTES = 18432;
constexpr int CW_BAR = 1024, CW_QHEAD = 0, CW_RESTDONE = 64, CW_ATTNDONE = 128, CW_NRM = 512  , CW_CUM = 704  ;
constexpr size_t WS_WIN = 1 * MiB, WS_WUPR = 50 * MiB, WS_WUPF = 54 * MiB, WS_WO = 58 * MiB, WS_WGATE = 66 * MiB, WS_WPLE = 74 * MiB, WS_WLORA = 75 * MiB;
constexpr size_t WS_ZRW = 76 * MiB, WS_ZFX = 204 * MiB, WS_ZG = 332 * MiB, WS_ZS = 460 * MiB, WS_LA = 476 * MiB, WS_CF = 492 * MiB, WS_SS1 = 493 * MiB, WS_SS2 = 495 * MiB, WS_PB = 497 * MiB, WS_FL = 505 * MiB, WS_END = 506 * MiB;
constexpr size_t WS_YR = WS_ZS;
constexpr size_t WS_T1 = WS_ZRW, WS_MG = WS_ZRW + 64 * MiB;
constexpr size_t WS_X1 = WS_ZFX, WS_X1B = WS_ZG, WS_PLE = WS_ZG + 64 * MiB;
constexpr size_t OUT_H = 0, OUT_DEC = 64 * MiB, OUT_AG = 96 * MiB, OUT_T1 = 0;
static_assert(WS_WIN + (size_t)NZ * D * 2 <= WS_WUPR && WS_ZS + (size_t)M * 256 * 4 <= WS_LA && WS_YR + (size_t)M * C * 2 <= WS_CF && WS_LA + (size_t)M * 256 * 2 <= WS_CF && WS_CF + (size_t)BATCH * H * T * 4 <= WS_SS1 && WS_SS1 + (size_t)M * 32 * 4 <= WS_SS2, "d_ws map");
constexpr int LDS_BYTES = 147456, MISC_OFF = LDS_BYTES - 256, RING_BYTES = MISC_OFF;
static_assert(WS_ZFX - WS_ZRW == WS_ZG - WS_ZFX, "EpiZ segment stride");
static_assert(scan2::LDS_BYTES <= RING_BYTES && attn_body::ATTN_LDS_BYTES <= RING_BYTES, "phase scratch fits the ring region");

#define GAS __attribute__((address_space(1)))
#define LAS __attribute__((address_space(3)))
typedef unsigned short bf16;
typedef unsigned v4u __attribute__((ext_vector_type(4)));
typedef unsigned v2u __attribute__((ext_vector_type(2)));
typedef float f32x4 __attribute__((ext_vector_type(4)));
__device__ __forceinline__ unsigned f2bf(float f) { unsigned u = __builtin_bit_cast(unsigned, f); return (u + 0x7fffu + ((u >> 16) & 1u)) >> 16; }
__device__ __forceinline__ unsigned pk2(float lo, float hi) { return f2bf(lo) | (f2bf(hi) << 16); }
__device__ __forceinline__ float wave_sum(float v) {
#pragma unroll
    for (int o = 1; o < 64; o <<= 1) v += __shfl_xor(v, o);
    return v;
}
#define RLX_AGENT __ATOMIC_RELAXED, __HIP_MEMORY_SCOPE_AGENT
#define LDS_WAIT() asm volatile("s_waitcnt lgkmcnt(0)" ::: "memory")
#define VM_WAIT() asm volatile("s_waitcnt vmcnt(0)" ::: "memory")
__device__ __forceinline__ unsigned long long rt() { return __builtin_amdgcn_s_memrealtime(); }
#define XB_TMO      128
#define XB_XCNT(j)  (256  + 64 * (j))
#define XB_XSUB(j)  (1280 + 64 * (j))
#define XB_XGEN(j)  (2304 + 64 * (j))
#define XB_TOP      3328
#define XB_TOPGEN   3392
#define XCD_BAR_WORDS 3456
#define XB_SPIN_CAP (1u << 18)

__device__ __forceinline__ unsigned xb_ld(unsigned* p)              { return __hip_atomic_load(p, __ATOMIC_RELAXED, __HIP_MEMORY_SCOPE_AGENT); }
__device__ __forceinline__ unsigned xb_add(unsigned* p, unsigned v) { return __hip_atomic_fetch_add(p, v, __ATOMIC_RELAXED, __HIP_MEMORY_SCOPE_AGENT); }
__device__ __forceinline__ unsigned xb_xcc_id() { return (unsigned)__builtin_amdgcn_s_getreg((3 << 11) | 20) & 0xFu; }
#define XB_SPIN(cond, bar) do { unsigned _sp = 0; while (cond) { __builtin_amdgcn_s_sleep(1); \
    if ((++_sp & 255u) == 0u) { if (xb_ld(&(bar)[XB_TMO])) break; if (_sp > XB_SPIN_CAP) { atomicAdd(&(bar)[XB_TMO], 1u); break; } } } } while (0)

struct XcdBarrier {
    unsigned* bar; unsigned x;
    volatile LAS unsigned* st;
};

__device__ __forceinline__ XcdBarrier xcd_barrier_post(unsigned* bar, volatile LAS unsigned* st, bool leader) {
    XcdBarrier b; b.bar = bar; b.x = xb_xcc_id(); b.st = st;
    if (leader) (void)xb_add(&bar[XB_XCNT(b.x)], 1u);
    return b;
}
__device__ __forceinline__ void xcd_barrier_complete(unsigned* bar, unsigned x, unsigned& nloc, unsigned& nx) {
    const unsigned G = gridDim.x * gridDim.y * gridDim.z;
    unsigned sum, cnt, mine, sp = 0u;
    for (;;) {
        sum = 0u; cnt = 0u; mine = 0u;
#pragma unroll
        for (unsigned j = 0; j < 16; ++j) { const unsigned c = xb_ld(&bar[XB_XCNT(j)]); sum += c; cnt += (c > 0u) ? 1u : 0u; mine = (j == x) ? c : mine; }
        if (sum == G) break;
        __builtin_amdgcn_s_sleep(1);
        if ((++sp & 255u) == 0u) { if (xb_ld(&bar[XB_TMO])) break; if (sp > XB_SPIN_CAP) { atomicAdd(&bar[XB_TMO], 1u); break; } }
    }
    nloc = mine > 0u ? mine : 1u; nx = cnt > 0u ? cnt : 1u;
}

__device__ __forceinline__ void xcd_barrier(const XcdBarrier& b, bool leader  ) {
    asm volatile("s_waitcnt vmcnt(0)" ::: "memory");
    __syncthreads();
    if (leader) {
        unsigned* bar = b.bar;
        __builtin_amdgcn_s_waitcnt(0);
        unsigned nloc = b.st[0], nx = b.st[1];
        if (nloc == 0u) { xcd_barrier_complete(bar, b.x, nloc, nx); b.st[0] = nloc; b.st[1] = nx; }
        const unsigned old = xb_add(&bar[XB_XSUB(b.x)], 1u);
        const unsigned gen = old / nloc;
        if (old + 1u == (gen + 1u) * nloc) {
            __builtin_amdgcn_fence(__ATOMIC_RELEASE, "agent");
            asm volatile("s_waitcnt vmcnt(0)" ::: "memory");
            const unsigned og = xb_add(&bar[XB_TOP], 1u);
            const unsigned tg = og / nx;
            if (og + 1u == (tg + 1u) * nx) xb_add(&bar[XB_TOPGEN], 1u);
            else XB_SPIN(xb_ld(&bar[XB_TOPGEN]) == tg, bar);
            __builtin_amdgcn_fence(__ATOMIC_ACQUIRE, "agent");
            xb_add(&bar[XB_XGEN(b.x)], 1u);
            asm volatile("s_waitcnt vmcnt(0)" ::: "memory");
        } else {
            XB_SPIN(xb_ld(&bar[XB_XGEN(b.x)]) == gen, bar);
            __builtin_amdgcn_fence(__ATOMIC_ACQUIRE, "agent");
            asm volatile("s_waitcnt vmcnt(0)" ::: "memory");
        }
    }
    __syncthreads();
}

__device__ __forceinline__ void tr_item(const float* W, int ldw, int n0, int cnt, bf16* WT, int ldt, int row_off, const float* ksc, LAS float* scr, int item, int nblk, int lane) {
    const int kb = item / nblk, nb = item % nblk, k0 = 64 * kb, nn0 = 32 * nb;
#pragma unroll 8
    for (int i = 0; i < 32; ++i) { const int kk = 2 * i + (lane >> 5), n = nn0 + (lane & 31); float v = (n < cnt) ? W[(size_t)(k0 + kk) * ldw + n0 + n] : 0.f; if (ksc) v *= ksc[k0 + kk]; scr[kk * 33 + (lane & 31)] = v; }
    asm volatile("s_waitcnt lgkmcnt(0)" ::: "memory");
    const int c = lane & 7;
#pragma unroll
    for (int j = 0; j < 4; ++j) { const int n = (lane >> 3) + 8 * j; const LAS float* s = scr + (8 * c) * 33 + n;
        v4u o; o.x = pk2(s[0 * 33], s[1 * 33]); o.y = pk2(s[2 * 33], s[3 * 33]); o.z = pk2(s[4 * 33], s[5 * 33]); o.w = pk2(s[6 * 33], s[7 * 33]);
        *(v4u*)(WT + (size_t)(row_off + nn0 + n) * ldt + k0 + 8 * c) = o; }
    asm volatile("s_waitcnt lgkmcnt(0)" ::: "memory");
}
__device__ __forceinline__ void tr_wg_item(const float* W, int ldw, int n0, int cnt, bf16* WT, int ldt, int row_off, const float* ksc, LAS unsigned char* scr, int item, int nblk, int tid) {
    const int kb = item / nblk, nb = item % nblk, k0 = 256 * kb, nn0 = 64 * nb, c = tid & 15, kr = tid >> 4;
    const bool live = (nn0 + 4 * c) < cnt;
#pragma unroll
    for (int ps = 0; ps < 4; ++ps) { const int k = 64 * ps + 2 * kr; f32x4 a = {0.f, 0.f, 0.f, 0.f}, b = a;
        if (live) { const float* src = W + (size_t)(k0 + k) * ldw + n0 + nn0 + 4 * c; a = __builtin_nontemporal_load((const f32x4*)src); b = __builtin_nontemporal_load((const f32x4*)(src + ldw)); }
        if (ksc) { a = a * ksc[k0 + k]; b = b * ksc[k0 + k + 1]; }
        const int kp = k >> 1, j = kp >> 2, w = kp & 3;
#pragma unroll
        for (int i = 0; i < 4; ++i) { const int n = 4 * c + i; *(LAS unsigned*)(scr + n * 512 + ((j ^ c) & 31) * 16 + w * 4) = pk2(a[i], b[i]); } }
    __syncthreads();
    { const int n = tid >> 3;
#pragma unroll
      for (int i = 0; i < 4; ++i) { const int j = (tid & 7) + 8 * i; const v4u v = *(const LAS v4u*)(scr + n * 512 + ((j ^ (n >> 2)) & 31) * 16);
          *(v4u*)(WT + (size_t)(row_off + nn0 + n) * ldt + k0 + 8 * j) = v; } }
    __syncthreads();
}
struct SubOrder {
    pg8::StaticOrder base; int off, brk, jump;
    __device__ void init(int M_, int ntiles, int Gs, int cs, int off_, int brk_, int jump_) { base.init(M_, ntiles * 256, Gs, cs); off = off_; brk = brk_; jump = jump_; }
    __device__ bool next(int i, pg8::Unit& u) const { if (!base.next(i, u)) return false; u.pn = u.pn + off + (u.pn >= brk ? jump : 0); return true; }
    __device__ __forceinline__ void a_ready(const pg8::Unit&) const {}
    __device__ __forceinline__ void done(const pg8::Unit&) const {}
};
struct P1Order { SubOrder A, B; bool hasB;
    __device__ bool next(int i, pg8::Unit& u) const { if (i < 4) return A.next(i, u); if (i == 4) return hasB ? B.next(0, u) : A.next(4, u); return false; }
    __device__ __forceinline__ void a_ready(const pg8::Unit&) const {} __device__ __forceinline__ void done(const pg8::Unit&) const {} };
struct RestOrder { SubOrder B;
    __device__ bool next(int i, pg8::Unit& u) const { return B.next(i + 1, u); }
    __device__ __forceinline__ void a_ready(const pg8::Unit&) const {} __device__ __forceinline__ void done(const pg8::Unit&) const {} };
struct PleOrder { int c;
    __device__ __forceinline__ bool next(int i, pg8::Unit& u) const { const int n = (c < 128) ? 2 : 4; if (i >= n) return false; const int t = (c < 128) ? 2 * c + i : 256 + 4 * (c - 128) + i; u.pm = t >> 3; u.pn = t & 7; return true; }
    __device__ __forceinline__ void a_ready(const pg8::Unit&) const {} __device__ __forceinline__ void done(const pg8::Unit&) const {} };
struct PairOrder { int c; bool pair; pg8::StaticOrder base;
    __device__ __forceinline__ bool next(int i, pg8::Unit& u) const { if (!pair) return base.next(i, u); if (i >= 2) return false; u.pm = 8 * (c & 7) + ((c >> 3) & 7); u.pn = 2 * (c >> 6) + i; return true; }
    __device__ __forceinline__ void a_ready(const pg8::Unit&) const {} __device__ __forceinline__ void done(const pg8::Unit&) const {} };
struct Args { const float* in[22]; float* out; unsigned char* ws; int ph_lo, ph_hi; };
enum { I_X = 0, I_P, I_NORMG, I_WIN, I_MU, I_W0, I_WLORA, I_A0, I_ALORA, I_KK, I_KA, I_RK, I_LNG, I_LNB, I_BF, I_WUPR, I_WUPF, I_WOUT, I_PLEPROJ, I_PLEGATE, I_PLENORMG, I_FINALG };
constexpr int N_PHASES = 10;

__global__ void __launch_bounds__(NTHREADS, 2) mk_fwd(Args args) {
    extern __shared__ __attribute__((aligned(16))) unsigned char lds[];
    LAS unsigned char* const L = (LAS unsigned char*)lds;
    const int wave = __builtin_amdgcn_readfirstlane(threadIdx.x >> 6);
    const int G = gridDim.x, bx = blockIdx.x, vcu = (G % 8 == 0) ? (bx % 8) * (G / 8) + bx / 8 : bx;
    const int gw = vcu * NWAVES + wave, NGW = G * NWAVES;
#define LANE_HERE const int lane = lane_id()
    unsigned char* const ws = args.ws; unsigned char* const ob = (unsigned char*)args.out;
    const int lo = args.ph_lo, hi = args.ph_hi;
#ifndef PROBE_TS_A
#define PROBE_TS_A -1
#define PROBE_TS_B -1
#endif
#ifndef PROBE_TS_OFF
#define PROBE_TS_OFF 0.f
#endif
#define TS_STAMP(i) do { if (PROBE_TS_A >= 0 && wave == 0 && lane_id() == 0) __hip_atomic_store((unsigned long long*)(ws + WS_CTL + 16384) + (i), __builtin_amdgcn_s_memrealtime(), __ATOMIC_RELAXED, __HIP_MEMORY_SCOPE_AGENT); } while (0)
#ifndef USE_CG_SYNC
#define USE_CG_SYNC 1
#endif
#ifndef PH_MASK
#define PH_MASK 0x3ff
#endif
#define IN(k) (((PH_MASK >> (k)) & 1) && lo <= (k) && (k) < hi)
#ifndef REP_MASK
#define REP_MASK 0
#endif
#define REPS(k) (((REP_MASK >> (k)) & 1) ? 2 : 1)
#define SEAM(k) do { if (IN(k) && IN((k) + 1)) { if ((k) == 0 && USE_CG_SYNC) cg::this_grid().sync(); else xcd_barrier(xbar, wave == 0 && lane_id() == 0); } if (bx == 0) TS_STAMP((k) + 1); } while (0)
    { volatile LAS unsigned* misc = (volatile LAS unsigned*)(L + MISC_OFF); if (threadIdx.x < 16) misc[threadIdx.x] = 0u; __syncthreads(); }
    const bool whole = (lo == 0 && hi == N_PHASES);
    if (whole && bx == 0) { unsigned* cw = (unsigned*)(ws + WS_CTL) + threadIdx.x;
#pragma unroll
        for (int i = 0; i < CTL_ZERO_BYTES / 4 / NTHREADS; ++i) __hip_atomic_store(cw + i * NTHREADS, 0u, __ATOMIC_RELAXED, __HIP_MEMORY_SCOPE_AGENT);
        asm volatile("s_waitcnt vmcnt(0)" ::: "memory"); }
    XcdBarrier xbar;
    if (!whole) xbar = xcd_barrier_post((unsigned*)(ws + WS_CTL) + CW_BAR, (volatile LAS unsigned*)(L + MISC_OFF) + 8, threadIdx.x == 0);
    bf16* const WinT = (bf16*)(ws + WS_WIN); bf16* const WupRT = (bf16*)(ws + WS_WUPR); bf16* const WupFT = (bf16*)(ws + WS_WUPF); bf16* const WoT = (bf16*)(ws + WS_WO);
    bf16* const WgT = (bf16*)(ws + WS_WGATE); bf16* const WpT = (bf16*)(ws + WS_WPLE); bf16* const WlT = (bf16*)(ws + WS_WLORA);
    bf16* const ZRW = (bf16*)(ws + WS_ZRW); bf16* const ZFX = (bf16*)(ws + WS_ZFX); bf16* const ZG = (bf16*)(ws + WS_ZG); float* const ZS = (float*)(ws + WS_ZS);
    bf16* const LA = (bf16*)(ws + WS_LA); bf16* const PB = (bf16*)(ws + WS_PB); float* const CF = (float*)(ws + WS_CF); float* const SS1 = (float*)(ws + WS_SS1); float* const SS2 = (float*)(ws + WS_SS2); bf16* const XT = (bf16*)(ws + WS_ZG + 64 * MiB)  ; float* const FLG = (float*)(ws + WS_FL);
    bf16* const T1 = ZFX + 1024  ; bf16* const MG = (bf16*)(ws + WS_MG); bf16* const X2B = MG; float* const X1 = (float*)(ws + WS_X1); bf16* const X1B = (bf16*)(ws + WS_X1B); bf16* const PLEB = (bf16*)(ob + OUT_H)  ;
    bf16* const HB = (bf16*)(ob + OUT_H); bf16* const DEC = (bf16*)(ob + OUT_DEC); bf16* const AG = (bf16*)(ob + OUT_AG); bf16* const YR = (bf16*)(ws + WS_YR);

    if (bx == 0) TS_STAMP(0);
    if (IN(0)) for (int rep_ = 0; rep_ < REPS(0); ++rep_) {
        LANE_HERE;
        const int tid = wave * 64 + lane;
        const float* w_in = args.in[I_WIN];
#define TRJOB(W_, K_, ldw_, n0_, cnt_, WT_, ldt_, ro_, ksc_) do { const int nblk_ = ((cnt_) + 63) / 64, items_ = ((K_) / 256) * nblk_; \
        for (int it = vcu; it < items_; it += G) tr_wg_item(W_, ldw_, n0_, cnt_, WT_, ldt_, ro_, ksc_, L, it, nblk_, tid); } while (0)
        TRJOB(w_in, D, N_IN, 0, 4096, WinT, D, 0, nullptr);
        TRJOB(w_in, D, N_IN, 4224, 4096, WinT, D, 4096, nullptr);
        TRJOB(w_in, D, N_IN, 8336, 4096, WinT, D, 8192, nullptr);
        TRJOB(w_in, D, N_IN, 4096, 128, WinT, D, 12288, nullptr);
        TRJOB(w_in, D, N_IN, 8320, 16, WinT, D, 12416, nullptr);
        for (int i = gw * 64 + lane; i < (NZ - 12480) * D / 8; i += NGW * 64) *(v4u*)(WinT + (size_t)12480 * D + (size_t)i * 8) = (v4u){0u, 0u, 0u, 0u};
        TRJOB(args.in[I_WUPR], C, D, 0, D, WupRT, C, 0, nullptr);
        TRJOB(args.in[I_WUPF], C, D, 0, D, WupFT, C, 0, nullptr);
        if (G != 256) {
        TRJOB(args.in[I_WOUT], D, D, 0, D, WoT, D, 0, nullptr);
        TRJOB(args.in[I_PLEGATE], D, D, 0, D, WgT, D, 0, args.in[I_PLENORMG]);
        TRJOB(args.in[I_PLEPROJ], PLE, D, 0, D, WpT, PLE, 0, nullptr); }
#undef TRJOB
        for (int i = gw * 64 + lane; i < 2048 * 32; i += NGW * 64) { const int n = i >> 5, kc = i & 31, k0 = 8 * kc; float v[8];
#pragma unroll
            for (int e = 0; e < 8; ++e) v[e] = 0.f;
            if (n < 1024 && k0 < 64) {
#pragma unroll
                for (int e = 0; e < 8; ++e) v[e] = args.in[I_WLORA][(size_t)(k0 + e) * C + n]; }
            else if (n >= 1024 && k0 >= 64 && k0 < 128) {
#pragma unroll
                for (int e = 0; e < 8; ++e) v[e] = args.in[I_ALORA][(size_t)(k0 - 64 + e) * C + (n - 1024)]; }
            *(v4u*)(WlT + (size_t)n * 256 + k0) = (v4u){pk2(v[0], v[1]), pk2(v[2], v[3]), pk2(v[4], v[5]), pk2(v[6], v[7])}; }
        { const float* x = args.in[I_X]; const float* g = args.in[I_NORMG]; f32x4 gv[8];
#pragma unroll
          for (int j = 0; j < 8; ++j) gv[j] = ((const f32x4*)g)[lane + 64 * j];
          for (int m = gw; m < M; m += NGW) { const f32x4* xr = (const f32x4*)(x + (size_t)m * D) + lane; f32x4 v[8]; float s = 0.f;
#pragma unroll
            for (int j = 0; j < 8; ++j) { v[j] = __builtin_nontemporal_load(xr + 64 * j); s += (v[j].x * v[j].x + v[j].y * v[j].y) + (v[j].z * v[j].z + v[j].w * v[j].w); }
            const float rstd = 1.f / sqrtf(wave_sum(s) * (1.f / D) + NORM_EPS);
            v2u* o8 = (v2u*)(HB + (size_t)m * D) + lane;
#pragma unroll
            for (int j = 0; j < 8; ++j) { const f32x4 y = v[j] * rstd * gv[j]; o8[64 * j] = (v2u){pk2(y.x, y.y), pk2(y.z, y.w)}; }
            if (G != 256 || !(lo == 0 && hi == N_PHASES)) {
            v2u* x8 = (v2u*)(XT + (size_t)(m >> 8) * 8 * 65536 + (size_t)(m & 255) * 256) + lane;
#pragma unroll
            for (int j = 0; j < 8; ++j) x8[(size_t)j * 16384] = (v2u){pk2(v[j].x, v[j].y), pk2(v[j].z, v[j].w)}; } } }
        { const float* p = args.in[I_P];
          for (int i = gw * 64 + lane; i < M * PLE / 8; i += NGW * 64) { const f32x4 a = __builtin_nontemporal_load((const f32x4*)p + 2 * i), b = __builtin_nontemporal_load((const f32x4*)p + 2 * i + 1);
            *(v4u*)(PB + (size_t)i * 8) = (v4u){pk2(a.x, a.y), pk2(a.z, a.w), pk2(b.x, b.y), pk2(b.z, b.w)}; } }
    }
    SEAM(0);
    if (whole) xbar = xcd_barrier_post((unsigned*)(ws + WS_CTL) + CW_BAR, (volatile LAS unsigned*)(L + MISC_OFF) + 8, wave == 0 && lane_id() == 0);
    if (IN(1)) for (int rep_ = 0; rep_ < REPS(1); ++rep_) {
        pg8::Gemm g{HB, WinT, M, NZ, D, D, D}; P1Order S; S.A.init(M, 17, G, bx, 0, 16, 32);
        const int NSCAN1 = BATCH * H; S.hasB = (bx >= NSCAN1) && (G == 256); S.B.init(M, 32, G - NSCAN1, bx >= NSCAN1 ? bx - NSCAN1 : 0, 16, 1 << 20, 0);
        pg8::EpiZ E{ZRW, (size_t)(WS_ZFX - WS_ZRW) / 2, ZS, attn_body::C2, (unsigned*)(ws + WS_CTL) + CW_NRM, FLG};
        pg8::gemm_phase<pg8::EpiZ, P1Order, true, true>(L, g, S, E, wave);
    }
    SEAM(1);
    if (IN(2)) {
        LANE_HERE;
        const float* mu = args.in[I_MU];
        {
            const float* __restrict__ zs = ZS; constexpr int NIT = 4; f32x4 a0[NIT], a1[NIT], p0[NIT], p1[NIT];
            const int i0 = gw * 64 + lane, istep = NGW * 64;
#pragma unroll
            for (int it = 0; it < NIT; ++it) { const int i = i0 + it * istep; const int m = i >> 4, c8 = i & 15; a0[it] = (f32x4){0.f, 0.f, 0.f, 0.f}; a1[it] = a0[it]; p0[it] = a0[it]; p1[it] = a0[it];
                if (i < M * 16) { const float* zc = zs + (size_t)m * 256 + 8 * c8; a0[it] = __builtin_nontemporal_load((const f32x4*)zc); a1[it] = __builtin_nontemporal_load((const f32x4*)(zc + 4));
                    if ((m & (T - 1)) != 0) { p0[it] = __builtin_nontemporal_load((const f32x4*)(zc - 256)); p1[it] = __builtin_nontemporal_load((const f32x4*)(zc - 252)); } } }
#pragma unroll
            for (int it = 0; it < NIT; ++it) { const int i = i0 + it * istep; const int m = i >> 4, c8 = i & 15;
                if (i < M * 16) { const f32x4 m0 = *(const f32x4*)(mu + 4096 + 8 * c8), m1 = *(const f32x4*)(mu + 4100 + 8 * c8);
                    f32x4 s0 = a0[it] + (p0[it] - a0[it]) * m0, s1 = a1[it] + (p1[it] - a1[it]) * m1;
                    if (c8 < 8) {
#pragma unroll
                        for (int e = 0; e < 4; ++e) { s0[e] = 1.f - 2.f * __builtin_amdgcn_rcpf(1.f + __builtin_amdgcn_exp2f(2.885390081777927f * s0[e])); s1[e] = 1.f - 2.f * __builtin_amdgcn_rcpf(1.f + __builtin_amdgcn_exp2f(2.885390081777927f * s1[e])); } }
                    *(v4u*)(LA + (size_t)m * 256 + 8 * c8) = (v4u){pk2(s0.x, s0.y), pk2(s0.z, s0.w), pk2(s1.x, s1.y), pk2(s1.z, s1.w)};
                    *(v4u*)(LA + (size_t)m * 256 + 128 + 8 * c8) = (v4u){0u, 0u, 0u, 0u}; } }
            for (int i = i0 + NIT * istep; i < M * 16; i += istep) {
                const int m = i >> 4, c8 = i & 15; const float* zc = zs + (size_t)m * 256 + 8 * c8; const f32x4 b0 = *(const f32x4*)zc, b1 = *(const f32x4*)(zc + 4); f32x4 q0 = {0.f, 0.f, 0.f, 0.f}, q1 = q0;
                if ((m & (T - 1)) != 0) { q0 = *(const f32x4*)(zc - 256); q1 = *(const f32x4*)(zc - 252); }
                const f32x4 m0 = *(const f32x4*)(mu + 4096 + 8 * c8), m1 = *(const f32x4*)(mu + 4100 + 8 * c8);
                f32x4 s0 = b0 + (q0 - b0) * m0, s1 = b1 + (q1 - b1) * m1;
                if (c8 < 8) {
#pragma unroll
                    for (int e = 0; e < 4; ++e) { s0[e] = 1.f - 2.f * __builtin_amdgcn_rcpf(1.f + __builtin_amdgcn_exp2f(2.885390081777927f * s0[e])); s1[e] = 1.f - 2.f * __builtin_amdgcn_rcpf(1.f + __builtin_amdgcn_exp2f(2.885390081777927f * s1[e])); } }
                *(v4u*)(LA + (size_t)m * 256 + 8 * c8) = (v4u){pk2(s0.x, s0.y), pk2(s0.z, s0.w), pk2(s1.x, s1.y), pk2(s1.z, s1.w)};
                *(v4u*)(LA + (size_t)m * 256 + 128 + 8 * c8) = (v4u){0u, 0u, 0u, 0u}; }
        }
    }
    SEAM(2);
    if (IN(3)) for (int rep_ = 0; rep_ < REPS(3); ++rep_) {
        pg8::Gemm g{LA, WlT, M, 2048, 128, 256, 256}; pg8::StaticOrder S; S.init(M, 2048, G, bx);
        pg8::EpiLora E{DEC, AG, args.in[I_W0], args.in[I_A0]};
        pg8::gemm_phase<pg8::EpiLora, pg8::StaticOrder, true, true>(L, g, S, E, wave);
    }
    SEAM(3);
    if (IN(4)) {
        unsigned* const ctl = (unsigned*)(ws + WS_CTL);
        const int NSCAN = BATCH * H;
        if (bx < NSCAN) {
            for (int rep_ = 0; rep_ < REPS(4); ++rep_) {
            scan2::Params SP{ZRW, DEC, AG, YR, args.in[I_MU], args.in[I_KK], args.in[I_KA], args.in[I_RK], args.in[I_LNG], args.in[I_LNB]};
            scan2::scan_head(L, SP, bx, wave, (PROBE_TS_A >= 20 && bx == 0) ? (unsigned long long*)(ws + WS_CTL + 16384) : nullptr); }
            if (bx == 0) TS_STAMP(16);
        } else {
            if (bx - NSCAN < 4 * BATCH) {
                const int lane = lane_id(), cq = bx - NSCAN, b = cq >> 2, qd = cq & 3, h = lane & 15, tq = lane >> 4, t0 = 1024 * qd + 128 * wave; const float bf = args.in[I_BF][h];
                const float* src = FLG + ((size_t)b * T + t0 + tq) * 16 + h; float xv[32];
#pragma unroll
                for (int j = 0; j < 32; ++j) xv[j] = src[(size_t)j * 64];
                float carry = 0.f;
#pragma unroll
                for (int j = 0; j < 32; ++j) { const float xx = xv[j] + bf; float y = fminf(xx, 0.f) - 0.6931471805599453f * __builtin_amdgcn_logf(1.f + __builtin_amdgcn_exp2f(-1.4426950408889634f * fabsf(xx)));
                    float n = __shfl_up(y, 16); if (tq >= 1) y += n; n = __shfl_up(y, 32); if (tq >= 2) y += n;
                    const float tot = __shfl(y, 48 + h); xv[j] = carry + y; carry += tot; }
                LAS float* wt = (LAS float*)(L + 1024);
                if (tq == 0) wt[wave * 16 + h] = carry;
                __syncthreads();
                float base = 0.f, all = 0.f;
#pragma unroll
                for (int w2 = 0; w2 < 8; ++w2) { const float v2 = wt[w2 * 16 + h]; all += v2; if (w2 < wave) base += v2; }
                float* qtot = (float*)(ws + WS_CTL + 24576);
                if (wave == 0 && tq == 0) __hip_atomic_store(qtot + (b * 4 + qd) * 16 + h, all, __ATOMIC_RELAXED, __HIP_MEMORY_SCOPE_AGENT);
                asm volatile("s_waitcnt vmcnt(0)" ::: "memory"); __syncthreads();
                if (wave == 0) { if (lane == 0) { __builtin_amdgcn_fence(__ATOMIC_RELEASE, "agent"); asm volatile("s_waitcnt vmcnt(0)" ::: "memory"); __hip_atomic_fetch_add(ctl + CW_CUM + b, 1u, __ATOMIC_RELAXED, __HIP_MEMORY_SCOPE_AGENT); }
                    unsigned sp = 0; while (__hip_atomic_load(ctl + CW_CUM + b, __ATOMIC_RELAXED, __HIP_MEMORY_SCOPE_AGENT) < 4u) { __builtin_amdgcn_s_sleep(2); if (++sp > (1u << 22)) break; }
                    __builtin_amdgcn_fence(__ATOMIC_ACQUIRE, "agent"); asm volatile("s_waitcnt vmcnt(0)" ::: "memory"); }
                __syncthreads();
                for (int q2 = 0; q2 < qd; ++q2) base += __hip_atomic_load(qtot + (b * 4 + q2) * 16 + h, __ATOMIC_RELAXED, __HIP_MEMORY_SCOPE_AGENT);
                float* dst = CF + ((size_t)(b * H + h)) * T + t0 + tq;
#pragma unroll
                for (int j = 0; j < 32; ++j) dst[4 * j] = (base + xv[j]) * 1.4426950408889634f;
                __syncthreads();
            }
            pg8::Gemm g{HB, WinT, M, NZ, D, D, D}; pg8::EpiZ E{ZRW, (size_t)(WS_ZFX - WS_ZRW) / 2, ZS, attn_body::C2, (unsigned*)(ws + WS_CTL) + CW_NRM, FLG};
            if (G == 256) { RestOrder S; S.B.init(M, 32, G - NSCAN, bx - NSCAN, 16, 1 << 20, 0); pg8::gemm_phase<pg8::EpiZ, RestOrder, true, true>(L, g, S, E, wave); }
            else { SubOrder S; S.init(M, 32, G - NSCAN, bx - NSCAN, 16, 1 << 20, 0); pg8::gemm_phase<pg8::EpiZ, SubOrder, true, true>(L, g, S, E, wave); }
            if (G == 256 && bx - NSCAN >= 128) {
                __syncthreads(); const int tid4 = wave * 64 + lane_id(), c4 = bx - NSCAN - 128;
                for (int it = c4; it < 544; it += 64) {
                    const bool isP = it < 32, isO = !isP && it < 288;
                    const float* W = isP ? args.in[I_PLEPROJ] : (isO ? args.in[I_WOUT] : args.in[I_PLEGATE]); bf16* WT = isP ? WpT : (isO ? WoT : WgT);
                    tr_wg_item(W, D, 0, D, WT, isP ? PLE : D, 0, (isP || isO) ? nullptr : args.in[I_PLENORMG], L, isP ? it : (isO ? it - 32 : it - 288), 32, tid4); }
            }
            asm volatile("s_waitcnt vmcnt(0)" ::: "memory"); __syncthreads();
            if (bx == 64) TS_STAMP(17);
            if (wave == 0 && lane_id() == 0) { __builtin_amdgcn_fence(__ATOMIC_RELEASE, "agent"); asm volatile("s_waitcnt vmcnt(0)" ::: "memory"); __hip_atomic_fetch_add(ctl + CW_RESTDONE, 1u, __ATOMIC_RELAXED, __HIP_MEMORY_SCOPE_AGENT); }
        }
        if (wave == 0) { unsigned sp = 0; while (__hip_atomic_load(ctl + CW_RESTDONE, __ATOMIC_RELAXED, __HIP_MEMORY_SCOPE_AGENT) < (unsigned)(G - NSCAN)) { __builtin_amdgcn_s_sleep(8); if (++sp > (1u << 22)) break; }
            __builtin_amdgcn_fence(__ATOMIC_ACQUIRE, "agent"); asm volatile("s_waitcnt vmcnt(0)" ::: "memory"); }
        __syncthreads();
        volatile LAS unsigned* slot = (volatile LAS unsigned*)(L + MISC_OFF);
        bool pend = false;
        for (;;) {
            if (wave == 0 && lane_id() == 0) slot[0] = atomicAdd(ctl + CW_QHEAD, 1u);
            asm volatile("s_waitcnt vmcnt(0)" ::: "memory"); __syncthreads();
            if (pend && wave == 0 && lane_id() == 0) { __builtin_amdgcn_fence(__ATOMIC_RELEASE, "agent"); asm volatile("s_waitcnt vmcnt(0)" ::: "memory"); __hip_atomic_fetch_add(ctl + CW_ATTNDONE, 1u, __ATOMIC_RELAXED, __HIP_MEMORY_SCOPE_AGENT); }
            const unsigned idx = slot[0];
            __syncthreads();
            if (idx >= 1024u) break;
            pend = true;
            const int qb = 15 - (int)(idx >> 6), bh = (int)(idx & 63u);
            const float bnd2 = 4.08f * sqrtf(__uint_as_float(__hip_atomic_load(ctl + CW_NRM + 2 * bh, __ATOMIC_RELAXED, __HIP_MEMORY_SCOPE_AGENT)) * __uint_as_float(__hip_atomic_load(ctl + CW_NRM + 2 * bh + 1, __ATOMIC_RELAXED, __HIP_MEMORY_SCOPE_AGENT)));
            attn_body::attn_unit<8>(bh >> 4, bh & 15, qb, (const attn_body::bf16*)ZFX, (const attn_body::bf16*)(ZFX + 1024), (const attn_body::bf16*)(ZFX + 2048), (const attn_body::bf16*)(ZFX + 3072), CF, (attn_body::bf16*)ZFX, (char*)lds, wave, bnd2);
        }
        if (bx >= NSCAN) {
            if (wave == 0) { unsigned sp = 0; while (__hip_atomic_load(ctl + CW_ATTNDONE, __ATOMIC_RELAXED, __HIP_MEMORY_SCOPE_AGENT) < 1024u) { __builtin_amdgcn_s_sleep(8); if (++sp > (1u << 22)) break; }
                __builtin_amdgcn_fence(__ATOMIC_ACQUIRE, "agent"); asm volatile("s_waitcnt vmcnt(0)" ::: "memory"); }
            __syncthreads();
            pg8::Gemm g{ZFX, WupFT, M, D, C, 4096, C}; pg8::StaticOrder S; S.init(M, D, G - NSCAN, bx - NSCAN); pg8::EpiT1 E{T1, ZG, 2048, 4096};
            pg8::gemm_phase<pg8::EpiT1, pg8::StaticOrder, true, true>(L, g, S, E, wave);
            if (G == 256) { pg8::Gemm g2{PB, WpT, M, D, PLE, PLE, PLE}; PleOrder S2; S2.c = bx - NSCAN; pg8::EpiPlainN E2{PLEB};
                pg8::gemm_phase<pg8::EpiPlainN, PleOrder, true, true>(L, g2, S2, E2, wave); }
            if (G == 256 && (lo == 0 && hi == N_PHASES)) {
                const int lane = lane_id(); const float* x = args.in[I_X];
                for (int m = (bx - NSCAN) * NWAVES + wave; m < M; m += 2 * (G - NSCAN) * NWAVES) { const int m2 = m + (G - NSCAN) * NWAVES; const bool two = m2 < M;
                    const f32x4* xr = (const f32x4*)(x + (size_t)m * D) + lane; const f32x4* xr2 = (const f32x4*)(x + (size_t)(two ? m2 : m) * D) + lane; f32x4 va[8], vb[8];
#pragma unroll
                    for (int j = 0; j < 8; ++j) { va[j] = __builtin_nontemporal_load(xr + 64 * j); vb[j] = __builtin_nontemporal_load(xr2 + 64 * j); }
                    v2u* xa = (v2u*)(XT + (size_t)(m >> 8) * 8 * 65536 + (size_t)(m & 255) * 256) + lane; v2u* xb = (v2u*)(XT + (size_t)(m2 >> 8) * 8 * 65536 + (size_t)(m2 & 255) * 256) + lane;
#pragma unroll
                    for (int j = 0; j < 8; ++j) { xa[(size_t)j * 16384] = (v2u){pk2(va[j].x, va[j].y), pk2(va[j].z, va[j].w)}; if (two) xb[(size_t)j * 16384] = (v2u){pk2(vb[j].x, vb[j].y), pk2(vb[j].z, vb[j].w)}; } }
            }
        }
    }
    if (IN(4)) { if (bx == 64) TS_STAMP(18); if (bx == 0) TS_STAMP(19); }
    SEAM(4);
    if (bx == 0) TS_STAMP(6);
    if (IN(6)) for (int rep_ = 0; rep_ < REPS(6); ++rep_) {
        pg8::Gemm g{YR, WupRT, M, D, C, C, C}; pg8::StaticOrder S; S.init(M, D, G, bx); pg8::EpiMerge E{T1, ZG, MG, 0, 4096};
        pg8::gemm_phase<pg8::EpiMerge, pg8::StaticOrder, true, true>(L, g, S, E, wave);
    }
    SEAM(6);
    if (IN(7)) for (int rep_ = 0; rep_ < REPS(7); ++rep_) {
        { pg8::Gemm g{MG, WoT, M, D, D, D, D}; PairOrder S; S.c = bx; S.pair = (G == 256); S.base.init(M, D, G, bx); pg8::EpiX1 E{XT, X1B, SS1};
          pg8::gemm_phase<pg8::EpiX1, PairOrder, true, true>(L, g, S, E, wave); }
        if (G != 256) { pg8::Gemm g{PB, WpT, M, D, PLE, PLE, PLE}; pg8::StaticOrder S; S.init(M, D, G, bx); pg8::EpiPlainN E{PLEB};
          pg8::gemm_phase<pg8::EpiPlainN, pg8::StaticOrder, true, true>(L, g, S, E, wave); }
    }
    SEAM(7);
    if (IN(8)) for (int rep_ = 0; rep_ < REPS(8); ++rep_) {
        pg8::Gemm g{X1B, WgT, M, D, D, D, D}; pg8::StaticOrder S; S.init(M, D, G, bx); pg8::EpiX2 E{X1B, PLEB, SS1, X2B, NORM_EPS};
        pg8::gemm_phase<pg8::EpiX2, pg8::StaticOrder, true, true>(L, g, S, E, wave);
    }
    SEAM(8);
    if (IN(9)) {
        LANE_HERE;
        const float* g = args.in[I_FINALG]; f32x4 gv[4][2];
#pragma unroll
        for (int j = 0; j < 4; ++j) { gv[j][0] = ((const f32x4*)g)[2 * (lane + 64 * j)]; gv[j][1] = ((const f32x4*)g)[2 * (lane + 64 * j) + 1]; }
        for (int m = gw; m < M; m += NGW) {
            const pg8::u32x4* xr = (const pg8::u32x4*)(X2B + (size_t)m * D) + lane; pg8::u32x4 xv[4];
#pragma unroll
            for (int j = 0; j < 4; ++j) xv[j] = __builtin_nontemporal_load(xr + 64 * j);
            f32x4 v[4][2]; float s = 0.f;
#pragma unroll
            for (int j = 0; j < 4; ++j) { pg8::unpack8(xv[j], v[j][0], v[j][1]);
                s += ((v[j][0].x * v[j][0].x + v[j][0].y * v[j][0].y) + (v[j][0].z * v[j][0].z + v[j][0].w * v[j][0].w)) + ((v[j][1].x * v[j][1].x + v[j][1].y * v[j][1].y) + (v[j][1].z * v[j][1].z + v[j][1].w * v[j][1].w)); }
            const float rstd = 1.f / sqrtf(wave_sum(s) * (1.f / D) + NORM_EPS);
            f32x4* orow = (f32x4*)(args.out + (size_t)m * D) + 2 * lane;
#pragma unroll
            for (int j = 0; j < 4; ++j) { orow[128 * j] = v[j][0] * rstd * gv[j][0]; orow[128 * j + 1] = v[j][1] * rstd * gv[j][1]; } }
        if (PROBE_TS_A >= 0 && bx == 0 && wave == 0 && lane == 0) { const unsigned long long* ts = (const unsigned long long*)(ws + WS_CTL + 16384);
            const unsigned long long ta = __hip_atomic_load(ts + (PROBE_TS_A < 0 ? 0 : PROBE_TS_A), __ATOMIC_RELAXED, __HIP_MEMORY_SCOPE_AGENT), tb = (PROBE_TS_B == 100) ? __builtin_amdgcn_s_memrealtime() : __hip_atomic_load(ts + ((PROBE_TS_B < 0 || PROBE_TS_B == 100) ? 0 : PROBE_TS_B), __ATOMIC_RELAXED, __HIP_MEMORY_SCOPE_AGENT);
            asm volatile("s_waitcnt vmcnt(0)" ::: "memory"); const float dus = (float)(long long)(tb - ta) * 0.01f; args.out[0] += floorf(8.f * log2f(fmaxf(dus, 1.f)) + 0.5f + PROBE_TS_OFF); }
    }
#undef IN
#undef SEAM
}

extern "C" void kernel_launch(void* const* d_in, const int* in_sizes, int n_in, void* d_out, int out_size, void* d_ws, size_t ws_size, hipStream_t stream) {
    static int grid = 0;
    if (grid == 0) {
        if (n_in != 22 || out_size != M * D || ws_size < WS_END) { fprintf(stderr, "kernel_launch: unexpected shapes (n_in %d, out %d, ws %zu)\n", n_in, out_size, ws_size); grid = -1; return; }
        int dev = 0, cus = 0, per_cu = 0;
        hipGetDevice(&dev); hipDeviceGetAttribute(&cus, hipDeviceAttributeMultiprocessorCount, dev);
        if (hipFuncSetAttribute((const void*)mk_fwd, hipFuncAttributeMaxDynamicSharedMemorySize, LDS_BYTES) != hipSuccess) { fprintf(stderr, "kernel_launch: hipFuncSetAttribute failed\n"); grid = -1; return; }
        if (hipOccupancyMaxActiveBlocksPerMultiprocessor(&per_cu, (const void*)mk_fwd, NTHREADS, LDS_BYTES) != hipSuccess || per_cu < 1) { fprintf(stderr, "kernel_launch: occupancy query says %d\n", per_cu); per_cu = 1; }
        (void)hipGetLastError();
        grid = cus;
        if (grid % 8 != 0 || grid > 256) grid = (grid > 256) ? 256 : (grid / 8) * 8;
    }
    if (grid <= 0) return;
#if MK_PER_PHASE_LAUNCHES
    hipMemsetAsync((char*)d_ws + WS_CTL, 0, CTL_ZERO_BYTES, stream);
#endif
    Args a{};
    for (int i = 0; i < 22; ++i) a.in[i] = (const float*)d_in[i];
    a.out = (float*)d_out; a.ws = (unsigned char*)d_ws;
#if MK_PER_PHASE_LAUNCHES
    for (int p = 0; p < N_PHASES; ++p) { a.ph_lo = p; a.ph_hi = p + 1; hipLaunchKernelGGL(mk_fwd, dim3(grid), dim3(NTHREADS), LDS_BYTES, stream, a); }
#else
    a.ph_lo = 0; a.ph_hi = N_PHASES;
    void* kargs[] = {&a};
    hipError_t e = hipLaunchCooperativeKernel((const void*)mk_fwd, dim3(grid), dim3(NTHREADS), kargs, LDS_BYTES, stream);
    if (e != hipSuccess) fprintf(stderr, "kernel_launch: cooperative launch failed: %s (grid %d)\n", hipGetErrorString(e), grid);
#endif
}
```
